# Optimizing an MI355X kernel written in HIP

```python
import jax, jax.numpy as jnp
from jax import lax
import numpy as np

D_MODEL = 1024
BATCH = 4
SEQ = 8192
DEPTH = 1
DEC_BATCH = 8
DEC_SEQ = 16
PAST_LEN = 1024

CHUNK = 64
GM_CHUNK = 128
GM_GROUPS = 8
GM_WIDTH = 1024
GM_GROUP_DIM = GM_WIDTH // GM_GROUPS
N_HEADS = 16
N_KV_HEADS = 2
HEAD_DIM = 64
Q_PER_KV = N_HEADS // N_KV_HEADS
WINDOW = 128
WINDOW_CHUNKS = WINDOW // CHUNK
BAND = (WINDOW_CHUNKS + 1) * CHUNK
QW = N_HEADS * HEAD_DIM
KVW = N_KV_HEADS * HEAD_DIM
D_FF = 2816
EPS = 1e-6
NEG = -1e30
SPLIT_POINTS = (GM_WIDTH, 2 * GM_WIDTH, 2 * GM_WIDTH + QW, 2 * GM_WIDTH + QW + KVW,
                2 * GM_WIDTH + QW + 2 * KVW, 2 * GM_WIDTH + QW + 2 * KVW + D_MODEL)
IN_COLS = 2 * GM_WIDTH + QW + 2 * KVW + 2 * D_MODEL

kernel_name = "hybrid_gmlp_swa_sink_streaming_step"


def _rmsnorm(x, g):
    xf = x.astype(jnp.float32)
    y = xf * lax.rsqrt(jnp.mean(xf * xf, axis=-1, keepdims=True) + EPS)
    return (y * g.astype(jnp.float32)).astype(x.dtype)


def _swiglu_half(x, g, w1, w3, w2):
    h = _rmsnorm(x, g)
    return x + 0.5 * ((jax.nn.silu(h @ w1) * (h @ w3)) @ w2)


def _mixer_inputs(x, g, w_in, gm_norm):
    h = _rmsnorm(x, g)
    u, v, q, k, va, ga, gb = jnp.split(h @ w_in, SPLIT_POINTS, axis=-1)
    u = jax.nn.gelu(u)
    v_n = _rmsnorm(jax.nn.gelu(v), gm_norm)
    return u, v_n, q, k, va, ga, gb


def _gm_mask():
    i = jnp.arange(GM_CHUNK)
    return (i[:, None] // CHUNK) >= (i[None, :] // CHUNK)


def _sink_attention(q, k, v, mask, sinks):
    s = jnp.einsum('bnqkgd,bnskd->bnkgqs', q, k).astype(jnp.float32) * (HEAD_DIM ** -0.5)
    s = jnp.where(mask[None, :, None, None], s, NEG)
    snk = jnp.broadcast_to(
        sinks.astype(jnp.float32).reshape(N_KV_HEADS, Q_PER_KV)[:, :, None, None],
        s.shape[:-1] + (1,))
    p = jax.nn.softmax(jnp.concatenate([s, snk], axis=-1), axis=-1)[..., :-1]
    return jnp.einsum('bnkgqs,bnskd->bnqkgd', p.astype(v.dtype), v)


def _band(t, nc):
    b = t.shape[0]
    tp = jnp.pad(t, ((0, 0), (WINDOW, 0), (0, 0), (0, 0)))
    tp = tp.reshape(b, nc + WINDOW_CHUNKS, CHUNK, N_KV_HEADS, HEAD_DIM)
    return jnp.concatenate([tp[:, i:i + nc] for i in range(WINDOW_CHUNKS + 1)], axis=2)


def _mix_prompt(u, v_n, q, k, va, ws, bs, sinks):
    b, t, _ = u.shape
    ws_m = ws * _gm_mask().astype(ws.dtype)
    vr = v_n.reshape(b, t // GM_CHUNK, GM_CHUNK, GM_GROUPS, GM_GROUP_DIM)
    sg = jnp.einsum('gij,bcjgd->bcigd', ws_m, vr) + bs.T[:, :, None]
    o_a = u * sg.reshape(b, t, GM_WIDTH)
    nc = t // CHUNK
    qc = q.reshape(b, nc, CHUNK, N_KV_HEADS, Q_PER_KV, HEAD_DIM)
    k4 = k.reshape(b, t, N_KV_HEADS, HEAD_DIM)
    v4 = va.reshape(b, t, N_KV_HEADS, HEAD_DIM)
    key_pos = jnp.arange(nc)[:, None] * CHUNK - WINDOW + jnp.arange(BAND)[None, :]
    mask = (key_pos >= 0)[:, None, :]
    o_b = _sink_attention(qc, _band(k4, nc), _band(v4, nc), mask, sinks).reshape(b, t, QW)
    keep = min(WINDOW, t)
    return o_a, o_b, k4[:, t - keep:], v4[:, t - keep:]


def _mix_sample(u, v_n, q, k, va, ck, cv, ws, bs, sinks):
    b, s, _ = u.shape
    wc = ck.shape[1]
    ws_m = (ws * _gm_mask().astype(ws.dtype))[:, :s, :s]
    vr = v_n.reshape(b, s, GM_GROUPS, GM_GROUP_DIM)
    sg = jnp.einsum('gij,bjgd->bigd', ws_m, vr) + bs[:, :s].T[:, :, None]
    o_a = u * sg.reshape(b, s, GM_WIDTH)
    k4 = k.reshape(b, s, N_KV_HEADS, HEAD_DIM)
    v4 = va.reshape(b, s, N_KV_HEADS, HEAD_DIM)
    q_pos = PAST_LEN + jnp.arange(s)
    k_pos = jnp.concatenate([PAST_LEN - wc + jnp.arange(wc), q_pos])
    dist = q_pos[:, None] // CHUNK - k_pos[None, :] // CHUNK
    mask = ((dist >= 0) & (dist <= WINDOW_CHUNKS))[None]
    keys = jnp.concatenate([ck, k4], axis=1)[:, None]
    vals = jnp.concatenate([cv, v4], axis=1)[:, None]
    qs = q.reshape(b, 1, s, N_KV_HEADS, Q_PER_KV, HEAD_DIM)
    o_b = _sink_attention(qs, keys, vals, mask, sinks).reshape(b, s, QW)
    return o_a, o_b, k4, v4, v_n


def _merge(x, o_a, o_b, ga, gb, w_pa, w_pb, w_out):
    m = jax.nn.sigmoid(ga) * (o_a @ w_pa) + jax.nn.sigmoid(gb) * (o_b @ w_pb)
    return x + m @ w_out


def setup_inputs(seed: int = 0) -> dict:
    key = jax.random.key(seed)
    ks = jax.random.split(key, 24)
    f32 = jnp.float32

    def nrm(k, shape, scale):
        return jax.random.normal(k, shape, f32) * scale

    wc = min(WINDOW, PAST_LEN)
    return {
        "x_prompt": nrm(ks[0], (BATCH, SEQ, D_MODEL), 1.0),
        "x_sample": nrm(ks[1], (DEC_BATCH, DEC_SEQ, D_MODEL), 1.0),
        "cache_k": nrm(ks[2], (DEPTH, DEC_BATCH, wc, N_KV_HEADS, HEAD_DIM), 1.0),
        "cache_v": nrm(ks[3], (DEPTH, DEC_BATCH, wc, N_KV_HEADS, HEAD_DIM), 1.0),
        "norm_ffn1": 1.0 + nrm(ks[4], (DEPTH, D_MODEL), 0.02),
        "ffn1_w1": nrm(ks[5], (DEPTH, D_MODEL, D_FF), D_MODEL ** -0.5),
        "ffn1_w3": nrm(ks[6], (DEPTH, D_MODEL, D_FF), D_MODEL ** -0.5),
        "ffn1_w2": nrm(ks[7], (DEPTH, D_FF, D_MODEL), D_FF ** -0.5),
        "norm_mix": 1.0 + nrm(ks[8], (DEPTH, D_MODEL), 0.02),
        "w_in": nrm(ks[9], (DEPTH, D_MODEL, IN_COLS), D_MODEL ** -0.5),
        "gm_norm": 1.0 + nrm(ks[10], (DEPTH, GM_WIDTH), 0.02),
        "gm_ws": nrm(ks[11], (DEPTH, GM_GROUPS, GM_CHUNK, GM_CHUNK), GM_CHUNK ** -0.5),
        "gm_bs": 1.0 + nrm(ks[12], (DEPTH, GM_GROUPS, GM_CHUNK), 0.02),
        "sinks": nrm(ks[13], (DEPTH, N_HEADS), 0.5),
        "w_pa": nrm(ks[14], (DEPTH, GM_WIDTH, D_MODEL), GM_WIDTH ** -0.5),
        "w_pb": nrm(ks[15], (DEPTH, QW, D_MODEL), QW ** -0.5),
        "w_out": nrm(ks[16], (DEPTH, D_MODEL, D_MODEL), D_MODEL ** -0.5),
        "norm_ffn2": 1.0 + nrm(ks[17], (DEPTH, D_MODEL), 0.02),
        "ffn2_w1": nrm(ks[18], (DEPTH, D_MODEL, D_FF), D_MODEL ** -0.5),
        "ffn2_w3": nrm(ks[19], (DEPTH, D_MODEL, D_FF), D_MODEL ** -0.5),
        "ffn2_w2": nrm(ks[20], (DEPTH, D_FF, D_MODEL), D_FF ** -0.5),
        "norm_final": 1.0 + nrm(ks[21], (D_MODEL,), 0.02),
    }


def reference(x_prompt, x_sample, cache_k, cache_v, norm_ffn1, ffn1_w1, ffn1_w3, ffn1_w2,
              norm_mix, w_in, gm_norm, gm_ws, gm_bs, sinks, w_pa, w_pb, w_out,
              norm_ffn2, ffn2_w1, ffn2_w3, ffn2_w2, norm_final):
    xp, xs = x_prompt, x_sample
    kp_l, vp_l, ks_l, vs_l, gs_l = [], [], [], [], []
    for l in range(DEPTH):
        xp = _swiglu_half(xp, norm_ffn1[l], ffn1_w1[l], ffn1_w3[l], ffn1_w2[l])
        xs = _swiglu_half(xs, norm_ffn1[l], ffn1_w1[l], ffn1_w3[l], ffn1_w2[l])
        u, v_n, q, k, va, ga, gb = _mixer_inputs(xp, norm_mix[l], w_in[l], gm_norm[l])
        o_a, o_b, nk, nv = _mix_prompt(u, v_n, q, k, va, gm_ws[l], gm_bs[l], sinks[l])
        xp = _merge(xp, o_a, o_b, ga, gb, w_pa[l], w_pb[l], w_out[l])
        kp_l.append(nk)
        vp_l.append(nv)
        u, v_n, q, k, va, ga, gb = _mixer_inputs(xs, norm_mix[l], w_in[l], gm_norm[l])
        o_a, o_b, nk, nv, gv = _mix_sample(u, v_n, q, k, va, cache_k[l], cache_v[l],
                                           gm_ws[l], gm_bs[l], sinks[l])
        xs = _merge(xs, o_a, o_b, ga, gb, w_pa[l], w_pb[l], w_out[l])
        ks_l.append(nk)
        vs_l.append(nv)
        gs_l.append(gv)
        xp = _swiglu_half(xp, norm_ffn2[l], ffn2_w1[l], ffn2_w3[l], ffn2_w2[l])
        xs = _swiglu_half(xs, norm_ffn2[l], ffn2_w1[l], ffn2_w3[l], ffn2_w2[l])
    y_prompt = _rmsnorm(xp, norm_final)
    y_sample = _rmsnorm(xs, norm_final)
    return (y_prompt, y_sample, jnp.stack(kp_l), jnp.stack(vp_l),
            jnp.stack(ks_l), jnp.stack(vs_l), jnp.stack(gs_l))
```

```cpp
#include <hip/hip_runtime.h>
#include <hip/hip_cooperative_groups.h>
#include <cstdio>
#include <cstdint>
namespace cg = cooperative_groups;


#ifndef MK_MULTI
#define MK_MULTI 0
#endif

#define GAS __attribute__((address_space(1)))
#define LAS __attribute__((address_space(3)))
typedef unsigned short bf16_t;
typedef short bf16x8 __attribute__((ext_vector_type(8)));
typedef float f32x4 __attribute__((ext_vector_type(4)));
typedef float f32x2 __attribute__((ext_vector_type(2)));
typedef unsigned u32x4 __attribute__((ext_vector_type(4)));
typedef unsigned u32x2 __attribute__((ext_vector_type(2)));

constexpr int DM = 1024, SEQ = 8192, NBATCH = 4, NPROMPT = NBATCH * SEQ, NSAMP = 128, MREAL = NPROMPT + NSAMP, MP = 33024  ;
constexpr int DFF = 2816, NUP = 2 * DFF, NIN = 5376;
constexpr float EPS = 1e-6f;
constexpr float LOG2E = 1.4426950408889634f;
constexpr float QSCALE = 0.125f * LOG2E;
constexpr int NWAVES = 8, NTHREADS = 512;
constexpr size_t OFF_YS = (size_t)NPROMPT * DM, OFF_KP = OFF_YS + (size_t)NSAMP * DM, OFF_VP = OFF_KP + 65536, OFF_KS = OFF_VP + 65536, OFF_VS = OFF_KS + 16384, OFF_GV = OFF_VS + 16384;
constexpr size_t MiB = 1u << 20;
constexpr size_t WS_W13_1 = 1 * MiB, WS_W2_1 = 12 * MiB, WS_WIN = 18 * MiB, WS_WPA = 29 * MiB, WS_WPB = 31 * MiB, WS_WOUT = 33 * MiB, WS_W13_2 = 35 * MiB, WS_W2_2 = 46 * MiB, WS_WM = 52 * MiB;
constexpr size_t WS_SSQ0 = 53 * MiB, WS_SSQ1 = 56 * MiB, WS_SSQ2 = 59 * MiB, WS_SSQ3 = 62 * MiB, WS_SSQV = 65 * MiB;
constexpr size_t WS_XB = 68 * MiB, WS_KV = 133 * MiB, WS_ACT = 150 * MiB, WS_G = 150 * MiB, WS_U = 280 * MiB, WS_VG = 345 * MiB, WS_Q = 410 * MiB, WS_END = 475 * MiB;
static_assert(WS_G + (size_t)MP * 2048 * 2 <= WS_U && WS_U + (size_t)MP * DM * 2 <= WS_VG && WS_VG + (size_t)MP * DM * 2 <= WS_Q && WS_Q + (size_t)MP * DM * 2 <= WS_END && WS_ACT + (size_t)MP * DFF * 2 <= WS_VG, "ws map");
static_assert(WS_SSQ0 + (size_t)MP * 64 <= WS_SSQ1 && WS_W13_1 + (size_t)NUP * DM * 2 <= WS_W2_1 && WS_W2_1 + (size_t)DM * DFF * 2 <= WS_WIN && WS_WIN + (size_t)NIN * DM * 2 <= WS_WPA && WS_W2_2 + (size_t)DM * DFF * 2 <= WS_WM, "ws map 2");
constexpr int LDS_BYTES = 147456;

__device__ __forceinline__ unsigned cvt_pk_bf16(float lo, float hi) { unsigned r; asm volatile("v_cvt_pk_bf16_f32 %0, %1, %2" : "=v"(r) : "v"(lo), "v"(hi)); return r; }
__device__ __forceinline__ float bf_lo(unsigned w) { return __uint_as_float(w << 16); }
__device__ __forceinline__ float bf_hi(unsigned w) { return __uint_as_float(w & 0xffff0000u); }
__device__ __forceinline__ float fast_sigmoid(float x) { return __builtin_amdgcn_rcpf(1.0f + __builtin_amdgcn_exp2f(-LOG2E * x)); }
__device__ __forceinline__ float silu_f(float x) { return x * fast_sigmoid(x); }
__device__ __forceinline__ float gelu_tanh(float x) { const float z = 1.5957691216057308f * (x + 0.044715f * x * x * x); return x * fast_sigmoid(z); }
__device__ __forceinline__ float wave_sum(float v) {
#pragma unroll
    for (int o = 1; o < 64; o <<= 1) v += __shfl_xor(v, o);
    return v;
}
__device__ __forceinline__ float row_rstd(const float* ssq, int row, int fq) {
    const f32x4 p = *(const f32x4*)(ssq + (size_t)row * 16 + 4 * fq);
    float s = (p.x + p.y) + (p.z + p.w);
    s += __shfl_xor(s, 16); s += __shfl_xor(s, 32);
    return rsqrtf(s * (1.0f / DM) + EPS);
}

__device__ __forceinline__ void rows_rstd8(const float* ssq, int row0, int fq, float (&rs)[8]) {
    f32x4 p[8];
#pragma unroll
    for (int t = 0; t < 8; ++t) p[t] = *(const f32x4*)(ssq + (size_t)(row0 + (t >> 2) * 128 + (t & 3) * 16) * 16 + 4 * fq);
    __builtin_amdgcn_sched_barrier(0);
#pragma unroll
    for (int t = 0; t < 8; ++t) { float s = (p[t].x + p[t].y) + (p[t].z + p[t].w); s += __shfl_xor(s, 16); s += __shfl_xor(s, 32); rs[t] = rsqrtf(s * (1.0f / DM) + EPS); }
}

namespace pg8 {
constexpr int BM = 256, BK = 64, HALF = 128, HTB = HALF * BK * 2, STAGE_BYTES = 8 * HTB, NXCD = 8, WGM = 4;
__host__ __device__ __forceinline__ int lds_byte(int r, int c) { const int st = (r >> 4) * 2 + (c >> 5), rr = r & 15, cc = c & 31, ob = rr * 64 + cc * 2; return st * 1024 + (ob ^ (((ob >> 9) & 1) << 5)); }
__host__ __device__ __forceinline__ void stage_rc(int b, int& R, int& C) { const int st = b / 1024, sb = b % 1024, swz = sb ^ (((sb >> 9) & 1) << 5); R = (st >> 1) * 16 + swz / 64; C = (st & 1) * 32 + (swz % 64) / 2; }
__host__ __device__ __forceinline__ int perm32(int rho) { const int n = rho >> 4, i = rho & 15; return 8 * (i >> 2) + 4 * n + (i & 3); }

struct Unit { int pm, pn, sel; };
struct Gemm { const bf16_t* A; const bf16_t* Bt; int K; size_t selA, selB; };

struct StaticOrder {
    int nM, nN, nwg, G, c, chain;
    __device__ void init(int M, int N, int G_, int c_, int chain_) { nM = M / BM; nN = N / BM; nwg = nM * nN; G = G_; c = c_; chain = chain_; }
    __device__ bool next(int i, Unit& u) const {
        const int ii = chain ? (i >> 1) : i;
        const long L = (long)ii * G + c; if (L >= nwg) return false;
        int wgid = (int)L; { const int q = nwg / NXCD, r = nwg % NXCD, xcd = wgid % NXCD, off = wgid / NXCD; wgid = (xcd < r ? xcd * (q + 1) : r * (q + 1) + (xcd - r) * q) + off; }
        const int nig = WGM * nN, gid = wgid / nig, fm = gid * WGM, gsz = (nM - fm) < WGM ? (nM - fm) : WGM;
        u.pm = fm + ((wgid % nig) % gsz); u.pn = (wgid % nig) / gsz; u.sel = chain ? (i & 1) : 0; return true;
    }
};

template <class Epi>
__device__ __forceinline__ void gemm_phase(LAS unsigned char* lds, const Gemm g, const StaticOrder& S, const Epi& E) {
    const int tid = threadIdx.x, wid = __builtin_amdgcn_readfirstlane(tid >> 6), lane = tid & 63, wr = wid >> 2, wc = wid & 3, fr = lane & 15, fq = lane >> 4;
    const int K = g.K, nt = K / BK;
    unsigned voffA[2], voffB[2];
#pragma unroll
    for (int i = 0; i < 2; ++i) { int R, C; stage_rc(tid * 16 + i * 8192, R, C); const int Rb = (R & ~31) + perm32(R & 31);
        voffA[i] = (unsigned)(R * K + C) * 2u; voffB[i] = (unsigned)(Rb * K + C) * 2u; }
    const size_t kstep = (size_t)(BK * 2);
    const size_t hstep = (size_t)HALF * K * 2;
    const size_t tstep = 2 * hstep;
    const unsigned ldsw = (unsigned)wid * 1024u;
    const int aoff = lds_byte(wr * 64 + fr, fq * 8), boff = lds_byte(wc * 32 + fr, fq * 8);
#define PG8_SA(b, h) (((b) * 2 + (h)) * HTB)
#define PG8_SB(b, h) ((4 + (b) * 2 + (h)) * HTB)
#define PG8_STAGE(bufoff, gbase, voff) do { _Pragma("unroll") for (int _i = 0; _i < 2; ++_i) \
        __builtin_amdgcn_global_load_lds((const unsigned*)((const char*)(gbase) + (voff)[_i]), (LAS unsigned*)(lds + (bufoff) + ldsw + _i * 8192), 16, 0, 0); } while (0)
#define PG8_LDA(dst, b, h) do { _Pragma("unroll") for (int m = 0; m < 4; ++m) _Pragma("unroll") for (int k = 0; k < 2; ++k) dst[m][k] = *(const LAS bf16x8*)(lds + PG8_SA(b, h) + aoff + m * 2048 + k * 1024); } while (0)
#define PG8_LDB(dst, b, h) do { _Pragma("unroll") for (int n = 0; n < 2; ++n) _Pragma("unroll") for (int k = 0; k < 2; ++k) dst[n][k] = *(const LAS bf16x8*)(lds + PG8_SB(b, h) + boff + n * 2048 + k * 1024); } while (0)
#define PG8_MMA(ai, bj, At, Bt) do { __builtin_amdgcn_s_setprio(1); _Pragma("unroll") for (int m = 0; m < 4; ++m) _Pragma("unroll") for (int n = 0; n < 2; ++n) _Pragma("unroll") for (int k = 0; k < 2; ++k) \
        acc[ai][bj][m][n] = __builtin_amdgcn_mfma_f32_16x16x32_bf16(Bt[n][k], At[m][k], acc[ai][bj][m][n], 0, 0, 0); __builtin_amdgcn_s_setprio(0); } while (0)
#define PG8_WAIT_V(n) asm volatile("s_waitcnt vmcnt(" #n ")" ::: "memory")
#define PG8_WAIT_L(n) asm volatile("s_waitcnt lgkmcnt(" #n ")" ::: "memory")
#define PG8_BAR __builtin_amdgcn_s_barrier()
#define PG8_SCHED __builtin_amdgcn_sched_barrier(0)
    Unit cur, nxt; int ui = 0;
    if (!S.next(0, cur)) return;
    f32x4 acc[2][2][4][2];
#pragma unroll
    for (int a = 0; a < 2; ++a)
#pragma unroll
        for (int b = 0; b < 2; ++b)
#pragma unroll
            for (int m = 0; m < 4; ++m)
#pragma unroll
                for (int n = 0; n < 2; ++n) acc[a][b][m][n] = (f32x4){0.f, 0.f, 0.f, 0.f};
    bf16x8 At[4][2], B0[2][2], B1[2][2];
    const char* cA = (const char*)g.A + (size_t)cur.pm * tstep + (size_t)cur.sel * g.selA; const char* cB = (const char*)g.Bt + (size_t)cur.pn * tstep + (size_t)cur.sel * g.selB;
    PG8_STAGE(PG8_SB(0, 0), cB, voffB); PG8_STAGE(PG8_SB(0, 1), cB + hstep, voffB); PG8_STAGE(PG8_SA(0, 0), cA, voffA); PG8_STAGE(PG8_SA(0, 1), cA + hstep, voffA);
    if (wr == 1) PG8_BAR;
    PG8_WAIT_V(2); PG8_BAR;
    PG8_STAGE(PG8_SB(1, 0), cB + kstep, voffB); PG8_STAGE(PG8_SA(1, 0), cA + kstep, voffA); PG8_STAGE(PG8_SB(1, 1), cB + hstep + kstep, voffB);
    PG8_WAIT_V(6); PG8_BAR;
    for (;;) {
        const bool has_next = S.next(ui + 1, nxt);
        const char* nA = has_next ? (const char*)g.A + (size_t)nxt.pm * tstep + (size_t)nxt.sel * g.selA : cA;
        const char* nB = has_next ? (const char*)g.Bt + (size_t)nxt.pn * tstep + (size_t)nxt.sel * g.selB : cB;
        for (int t = 0; t < nt; t += 2) {
            const bool last = (t == nt - 2);
            const char* a1 = cA + (size_t)(t + 1) * kstep;
            const char* a2 = last ? nA : cA + (size_t)(t + 2) * kstep; const char* b2 = last ? nB : cB + (size_t)(t + 2) * kstep;
            const char* a3 = a2 + kstep; const char* b3 = b2 + kstep;
            PG8_LDB(B0, 0, 0); PG8_LDB(B1, 0, 1); PG8_SCHED; PG8_LDA(At, 0, 0); PG8_STAGE(PG8_SA(1, 1), a1 + hstep, voffA);
            PG8_WAIT_V(8); PG8_WAIT_L(0); PG8_BAR; PG8_MMA(0, 0, At, B0); PG8_MMA(0, 1, At, B1); PG8_BAR; PG8_SCHED;
            PG8_LDA(At, 0, 1); PG8_STAGE(PG8_SB(0, 0), b2, voffB); PG8_STAGE(PG8_SB(0, 1), b2 + hstep, voffB); PG8_STAGE(PG8_SA(0, 0), a2, voffA);
            PG8_WAIT_V(8); PG8_WAIT_L(0); PG8_BAR; PG8_MMA(1, 0, At, B0); PG8_MMA(1, 1, At, B1); PG8_BAR; PG8_SCHED;
            PG8_LDB(B0, 1, 0); PG8_LDB(B1, 1, 1); PG8_SCHED; PG8_LDA(At, 1, 0); PG8_STAGE(PG8_SA(0, 1), a2 + hstep, voffA);
            PG8_WAIT_V(8); PG8_WAIT_L(0); PG8_BAR; PG8_MMA(0, 0, At, B0); PG8_MMA(0, 1, At, B1); PG8_BAR; PG8_SCHED;
            PG8_LDA(At, 1, 1); PG8_STAGE(PG8_SB(1, 0), b3, voffB); PG8_STAGE(PG8_SB(1, 1), b3 + hstep, voffB); PG8_STAGE(PG8_SA(1, 0), a3, voffA);
            PG8_WAIT_V(8); PG8_WAIT_L(0); PG8_BAR; PG8_MMA(1, 0, At, B0); PG8_MMA(1, 1, At, B1); PG8_BAR; PG8_SCHED;
        }
        if (wr == 0) PG8_BAR;
        E(acc, cur, wr, wc, fr, fq);
        if (!has_next) break;
        if (!E.keep(cur)) {
#pragma unroll
            for (int a = 0; a < 2; ++a)
#pragma unroll
                for (int b = 0; b < 2; ++b)
#pragma unroll
                    for (int m = 0; m < 4; ++m)
#pragma unroll
                        for (int n = 0; n < 2; ++n) acc[a][b][m][n] = (f32x4){0.f, 0.f, 0.f, 0.f};
        }
        cur = nxt; cA = nA; cB = nB; ++ui;
        if (wr == 1) PG8_BAR;
    }
    PG8_WAIT_V(0);
    PG8_BAR;
#undef PG8_SA
#undef PG8_SB
#undef PG8_STAGE
#undef PG8_LDA
#undef PG8_LDB
#undef PG8_MMA
#undef PG8_WAIT_V
#undef PG8_WAIT_L
#undef PG8_BAR
#undef PG8_SCHED
}

struct EpiSwiglu {
    bf16_t* ACT; const float* ssq;
    __device__ __forceinline__ bool keep(const Unit&) const { return false; }
    __device__ __forceinline__ void operator()(f32x4 (&acc)[2][2][4][2], const Unit& u, int wr, int wc, int fr, int fq) const {
        const int row0 = u.pm * BM + wr * 64 + fr, col0 = u.pn * 128 + wc * 32 + 8 * fq;
        float rs[8]; rows_rstd8(ssq, row0, fq, rs);
#pragma unroll
        for (int ai = 0; ai < 2; ++ai)
#pragma unroll
            for (int m = 0; m < 4; ++m) {
                const int row = row0 + ai * HALF + m * 16; const float s = rs[ai * 4 + m];
                float o[8];
#pragma unroll
                for (int n = 0; n < 2; ++n)
#pragma unroll
                    for (int i = 0; i < 4; ++i) { const float g1 = acc[ai][0][m][n][i] * s, g3 = acc[ai][1][m][n][i] * s; o[n * 4 + i] = silu_f(g1) * g3; }
                u32x4 w; w.x = cvt_pk_bf16(o[0], o[1]); w.y = cvt_pk_bf16(o[2], o[3]); w.z = cvt_pk_bf16(o[4], o[5]); w.w = cvt_pk_bf16(o[6], o[7]);
                *(u32x4*)(ACT + (size_t)row * DFF + col0) = w;
            }
    }
};
struct EpiResid {
    const float* xp; const float* xs; float* outf; bf16_t* XB; float* ssq_out; float alpha; int base_is_out;
    __device__ __forceinline__ bool keep(const Unit&) const { return false; }
    __device__ __forceinline__ void operator()(f32x4 (&acc)[2][2][4][2], const Unit& u, int wr, int wc, int fr, int fq) const {
        const int row0 = u.pm * BM + wr * 64 + fr, col0 = u.pn * BM + wc * 32 + 8 * fq;
#pragma unroll
        for (int ai = 0; ai < 2; ++ai)
#pragma unroll
            for (int m = 0; m < 4; ++m) {
                const int row = row0 + ai * HALF + m * 16; const bool valid = row < MREAL;
                const float* bp = base_is_out ? outf + (size_t)row * DM : (row < NPROMPT ? xp + (size_t)row * DM : xs + (size_t)(row - NPROMPT) * DM);
                float q = 0.f;
#pragma unroll
                for (int bj = 0; bj < 2; ++bj) {
                    const int c = col0 + bj * HALF;
                    f32x4 b0 = (f32x4){0.f, 0.f, 0.f, 0.f}, b1 = b0;
                    if (valid) { b0 = *(const f32x4*)(bp + c); b1 = *(const f32x4*)(bp + c + 4); }
                    const f32x4 v0 = b0 + acc[ai][bj][m][0] * alpha, v1 = b1 + acc[ai][bj][m][1] * alpha;
                    q += (v0.x * v0.x + v0.y * v0.y) + (v0.z * v0.z + v0.w * v0.w) + (v1.x * v1.x + v1.y * v1.y) + (v1.z * v1.z + v1.w * v1.w);
                    if (valid) { *(f32x4*)(outf + (size_t)row * DM + c) = v0; *(f32x4*)(outf + (size_t)row * DM + c + 4) = v1; }
                    if (XB) { u32x4 w; w.x = cvt_pk_bf16(v0.x, v0.y); w.y = cvt_pk_bf16(v0.z, v0.w); w.z = cvt_pk_bf16(v1.x, v1.y); w.w = cvt_pk_bf16(v1.z, v1.w);
                        *(u32x4*)(XB + (size_t)row * DM + c) = w; }
                }
                q += __shfl_xor(q, 16); q += __shfl_xor(q, 32);
                if (fq == 0) ssq_out[(size_t)row * 16 + u.pn * 4 + wc] = q;
            }
    }
};
struct EpiWin {
    bf16_t *U, *VG, *Q, *KV, *G; const float* ssq1; float* ssqv; float* outf;
    __device__ __forceinline__ bool keep(const Unit&) const { return false; }
    __device__ __forceinline__ void operator()(f32x4 (&acc)[2][2][4][2], const Unit& u, int wr, int wc, int fr, int fq) const {
        const int pn = u.pn;
        bf16_t* dst; int ldd = DM, cbase; int act; float scale = 1.0f; bool want_ssq = false, kvt = false;
        if (pn < 4)       { dst = U;  cbase = pn * 256;        act = 1; }
        else if (pn < 8)  { dst = VG; cbase = (pn - 4) * 256;  act = 1; want_ssq = true; }
        else if (pn < 12) { dst = Q;  cbase = (pn - 8) * 256;  act = 0; scale = QSCALE; }
        else if (pn == 12){ dst = KV; cbase = 0; ldd = 256;    act = 0; kvt = true; }
        else if (pn < 17) { dst = G;  cbase = (pn - 13) * 256; act = 2; }
        else              { dst = G + (size_t)MP * DM; cbase = (pn - 17) * 256; act = 2; }
        const float zc1 = act == 1 ? 1.5957691216057308f : 1.0f, zc3 = act == 1 ? 1.5957691216057308f * 0.044715f : 0.0f;
        const int row0 = u.pm * BM + wr * 64 + fr, c0 = wc * 32 + 8 * fq;
        float rs[8]; rows_rstd8(ssq1, row0, fq, rs);
#pragma unroll
        for (int ai = 0; ai < 2; ++ai)
#pragma unroll
            for (int m = 0; m < 4; ++m) {
                const int row = row0 + ai * HALF + m * 16; const float s = rs[ai * 4 + m];
                float q = 0.f;
#pragma unroll
                for (int bj = 0; bj < 2; ++bj) {
                    const int c = c0 + bj * HALF;
                    float o[8];
#pragma unroll
                    for (int n = 0; n < 2; ++n)
#pragma unroll
                        for (int i = 0; i < 4; ++i) {
                            const float x = acc[ai][bj][m][n][i] * s;
                            const float sg = fast_sigmoid(x * (zc1 + zc3 * x * x));
                            float v = act == 0 ? x * scale : (act == 1 ? x * sg : sg);
                            q += v * v;
                            o[n * 4 + i] = v;
                        }
                    u32x4 w; w.x = cvt_pk_bf16(o[0], o[1]); w.y = cvt_pk_bf16(o[2], o[3]); w.z = cvt_pk_bf16(o[4], o[5]); w.w = cvt_pk_bf16(o[6], o[7]);
                    *(u32x4*)(dst + (size_t)row * ldd + cbase + c) = w;
                    if (kvt) {
                        const int rowu = __builtin_amdgcn_readfirstlane(row);
                        const int tu = rowu & (SEQ - 1);
                        if (rowu < NPROMPT ? (tu >= SEQ - 128) : (rowu < MREAL)) {
                            float* fd = rowu < NPROMPT ? outf + (bj == 0 ? OFF_KP : OFF_VP) + ((size_t)(row >> 13) * 128 + ((row & (SEQ - 1)) - (SEQ - 128))) * 128 + c0
                                                       : outf + (bj == 0 ? OFF_KS : OFF_VS) + (size_t)(row - NPROMPT) * 128 + c0;
                            *(f32x4*)fd = (f32x4){o[0], o[1], o[2], o[3]}; *(f32x4*)(fd + 4) = (f32x4){o[4], o[5], o[6], o[7]};
                        }
                    }
                }
                if (want_ssq) { q += __shfl_xor(q, 16); q += __shfl_xor(q, 32); if (fq == 0) ssqv[(size_t)row * 16 + (pn - 4) * 4 + wc] = q; }
            }
    }
};
struct EpiGate {
    const bf16_t* G; bf16_t* MB; int second;
    __device__ __forceinline__ bool keep(const Unit&) const { return false; }
    __device__ __forceinline__ void operator()(f32x4 (&acc)[2][2][4][2], const Unit& u, int wr, int wc, int fr, int fq) const {
        const int row0 = u.pm * BM + wr * 64 + fr, col0 = u.pn * BM + wc * 32 + 8 * fq;
        const bf16_t* Gs = G + (second ? (size_t)MP * DM : (size_t)0);
#pragma unroll
        for (int ai = 0; ai < 2; ++ai)
#pragma unroll
            for (int m = 0; m < 4; ++m) {
                const int row = row0 + ai * HALF + m * 16;
#pragma unroll
                for (int bj = 0; bj < 2; ++bj) {
                    const int c = col0 + bj * HALF;
                    const u32x4 gg = *(const u32x4*)(Gs + (size_t)row * DM + c);
                    const float gv[8] = {bf_lo(gg.x), bf_hi(gg.x), bf_lo(gg.y), bf_hi(gg.y), bf_lo(gg.z), bf_hi(gg.z), bf_lo(gg.w), bf_hi(gg.w)};
                    float o[8];
#pragma unroll
                    for (int n = 0; n < 2; ++n)
#pragma unroll
                        for (int i = 0; i < 4; ++i) o[n * 4 + i] = acc[ai][bj][m][n][i] * gv[n * 4 + i];
                    if (second) {
                        const u32x4 tt = *(const u32x4*)(MB + (size_t)row * DM + c);
                        o[0] += bf_lo(tt.x); o[1] += bf_hi(tt.x); o[2] += bf_lo(tt.y); o[3] += bf_hi(tt.y); o[4] += bf_lo(tt.z); o[5] += bf_hi(tt.z); o[6] += bf_lo(tt.w); o[7] += bf_hi(tt.w);
                    }
                    u32x4 w; w.x = cvt_pk_bf16(o[0], o[1]); w.y = cvt_pk_bf16(o[2], o[3]); w.z = cvt_pk_bf16(o[4], o[5]); w.w = cvt_pk_bf16(o[6], o[7]);
                    *(u32x4*)(MB + (size_t)row * DM + c) = w;
                }
            }
    }
};
struct EpiPlain {
    bf16_t* O;
    __device__ __forceinline__ bool keep(const Unit&) const { return false; }
    __device__ __forceinline__ void operator()(f32x4 (&acc)[2][2][4][2], const Unit& u, int wr, int wc, int fr, int fq) const {
        const int row0 = u.pm * BM + wr * 64 + fr, col0 = u.pn * BM + wc * 32 + 8 * fq;
#pragma unroll
        for (int ai = 0; ai < 2; ++ai)
#pragma unroll
            for (int m = 0; m < 4; ++m) {
                const int row = row0 + ai * HALF + m * 16;
#pragma unroll
                for (int bj = 0; bj < 2; ++bj) {
                    const int c = col0 + bj * HALF;
                    const f32x4 a = acc[ai][bj][m][0], b = acc[ai][bj][m][1];
                    u32x4 w; w.x = cvt_pk_bf16(a.x, a.y); w.y = cvt_pk_bf16(a.z, a.w); w.z = cvt_pk_bf16(b.x, b.y); w.w = cvt_pk_bf16(b.z, b.w);
                    *(u32x4*)(O + (size_t)row * DM + c) = w;
                }
            }
    }
};
}

template <class F>
__device__ __forceinline__ void sample_gemm(LAS unsigned char* lds, const bf16_t* As, const bf16_t* Bt, int K, int jj, int wave, int lane, const F& f) {
    const int fr = lane & 15, fq = lane >> 4, j = jj >> 1, rt = (jj & 1) * 4 + (wave & 3), kh = wave >> 2, K2 = K >> 1;
    const bf16_t* ap = As + (size_t)(rt * 16 + fr) * K + kh * K2 + 8 * fq;
    const bf16_t* bp = Bt + (size_t)(j * 16 + fr) * K + kh * K2 + 8 * fq;
    f32x4 acc0 = (f32x4){0.f, 0.f, 0.f, 0.f}, acc1 = acc0;
    int k = 0;
#pragma unroll 1
    for (; k + 256 <= K2; k += 256) {
        bf16x8 a[8], b[8];
#pragma unroll
        for (int t = 0; t < 8; ++t) { a[t] = *(const bf16x8*)(ap + k + 32 * t); b[t] = *(const bf16x8*)(bp + k + 32 * t); }
        __builtin_amdgcn_sched_barrier(0);
#pragma unroll
        for (int t = 0; t < 8; t += 2) { acc0 = __builtin_amdgcn_mfma_f32_16x16x32_bf16(b[t], a[t], acc0, 0, 0, 0); acc1 = __builtin_amdgcn_mfma_f32_16x16x32_bf16(b[t + 1], a[t + 1], acc1, 0, 0, 0); }
        __builtin_amdgcn_sched_barrier(0);
    }
#pragma unroll 1
    for (; k < K2; k += 128) {
        bf16x8 a[4], b[4];
#pragma unroll
        for (int t = 0; t < 4; ++t) { a[t] = *(const bf16x8*)(ap + k + 32 * t); b[t] = *(const bf16x8*)(bp + k + 32 * t); }
        __builtin_amdgcn_sched_barrier(0);
#pragma unroll
        for (int t = 0; t < 4; t += 2) { acc0 = __builtin_amdgcn_mfma_f32_16x16x32_bf16(b[t], a[t], acc0, 0, 0, 0); acc1 = __builtin_amdgcn_mfma_f32_16x16x32_bf16(b[t + 1], a[t + 1], acc1, 0, 0, 0); }
        __builtin_amdgcn_sched_barrier(0);
    }
    f32x4 acc = acc0 + acc1;
    LAS f32x4* xch = (LAS f32x4*)lds;
    if (kh == 1) xch[(wave & 3) * 64 + lane] = acc;
    __syncthreads();
    if (kh == 0) { acc += xch[(wave & 3) * 64 + lane]; f(acc, NPROMPT + rt * 16 + fr, j, fq); }
    __syncthreads();
}
struct SkResid {
    const float* base; float* outf; bf16_t* XB; float* ssq_out; float alpha;
    __device__ __forceinline__ void operator()(const f32x4 a, int row, int j, int fq) const {
        const int c = j * 16 + 4 * fq;
        const f32x4 v = *(const f32x4*)(base + (size_t)row * DM + c) + a * alpha;
        float q = (v.x * v.x + v.y * v.y) + (v.z * v.z + v.w * v.w);
        *(f32x4*)(outf + (size_t)row * DM + c) = v;
        if (XB) { u32x2 w; w.x = cvt_pk_bf16(v.x, v.y); w.y = cvt_pk_bf16(v.z, v.w); *(u32x2*)(XB + (size_t)row * DM + c) = w; }
        q += __shfl_xor(q, 16); q += __shfl_xor(q, 32);
        if (fq == 0) atomicAdd(ssq_out + (size_t)row * 16 + (j >> 2), q);
    }
};
struct SkGate {
    const bf16_t* G; bf16_t* MB; int second;
    __device__ __forceinline__ void operator()(const f32x4 a, int row, int j, int fq) const {
        const bf16_t* Gs = G + (second ? (size_t)MP * DM : (size_t)0);
        const int c = j * 16 + 4 * fq;
        const u32x2 gg = *(const u32x2*)(Gs + (size_t)row * DM + c);
        float o0 = a.x * bf_lo(gg.x), o1 = a.y * bf_hi(gg.x), o2 = a.z * bf_lo(gg.y), o3 = a.w * bf_hi(gg.y);
        if (second) { const u32x2 tt = *(const u32x2*)(MB + (size_t)row * DM + c); o0 += bf_lo(tt.x); o1 += bf_hi(tt.x); o2 += bf_lo(tt.y); o3 += bf_hi(tt.y); }
        u32x2 w; w.x = cvt_pk_bf16(o0, o1); w.y = cvt_pk_bf16(o2, o3);
        *(u32x2*)(MB + (size_t)row * DM + c) = w;
    }
};

__device__ __forceinline__ void sample_up(LAS unsigned char* lds, const bf16_t* XBs, const bf16_t* W13, const float* ssq, bf16_t* ACT, int jj, int wave, int lane) {
    const int fr = lane & 15, fq = lane >> 4, j = jj >> 1, rt = (jj & 1) * 4 + (wave & 3), kh = wave >> 2;
    const int c0 = j * 16;
    const bf16_t* ap = XBs + (size_t)(rt * 16 + fr) * DM + kh * 512 + 8 * fq;
    const bf16_t* b1 = W13 + (size_t)((c0 >> 7) * 256 + (c0 & 127) + fr) * DM + kh * 512 + 8 * fq;
    const bf16_t* b3 = b1 + (size_t)128 * DM;
    f32x4 g1 = (f32x4){0.f, 0.f, 0.f, 0.f}, g3 = g1;
#pragma unroll 1
    for (int k = 0; k < 512; k += 256) {
        bf16x8 a[8], p[8], q[8];
#pragma unroll
        for (int t = 0; t < 8; ++t) { a[t] = *(const bf16x8*)(ap + k + 32 * t); p[t] = *(const bf16x8*)(b1 + k + 32 * t); q[t] = *(const bf16x8*)(b3 + k + 32 * t); }
        __builtin_amdgcn_sched_barrier(0);
#pragma unroll
        for (int t = 0; t < 8; ++t) { g1 = __builtin_amdgcn_mfma_f32_16x16x32_bf16(p[t], a[t], g1, 0, 0, 0); g3 = __builtin_amdgcn_mfma_f32_16x16x32_bf16(q[t], a[t], g3, 0, 0, 0); }
        __builtin_amdgcn_sched_barrier(0);
    }
    LAS f32x4* xch = (LAS f32x4*)lds;
    if (kh == 1) { xch[((wave & 3) * 2 + 0) * 64 + lane] = g1; xch[((wave & 3) * 2 + 1) * 64 + lane] = g3; }
    __syncthreads();
    if (kh == 0) {
        g1 += xch[((wave & 3) * 2 + 0) * 64 + lane]; g3 += xch[((wave & 3) * 2 + 1) * 64 + lane];
        const int row = NPROMPT + rt * 16 + fr;
        const f32x4* sp = (const f32x4*)(ssq + (size_t)row * 16); const f32x4 s0 = sp[0], s1 = sp[1], s2 = sp[2], s3 = sp[3];
        const float ss = ((s0.x + s0.y) + (s0.z + s0.w)) + ((s1.x + s1.y) + (s1.z + s1.w)) + ((s2.x + s2.y) + (s2.z + s2.w)) + ((s3.x + s3.y) + (s3.z + s3.w));
        const float rs = rsqrtf(ss * (1.0f / DM) + EPS);
        u32x2 w; w.x = cvt_pk_bf16(silu_f(g1.x * rs) * (g3.x * rs), silu_f(g1.y * rs) * (g3.y * rs)); w.y = cvt_pk_bf16(silu_f(g1.z * rs) * (g3.z * rs), silu_f(g1.w * rs) * (g3.w * rs));
        *(u32x2*)(ACT + (size_t)row * DFF + c0 + 4 * fq) = w;
    }
    __syncthreads();
}

__device__ __forceinline__ void p0_transpose_item(const float* W, int K, int N, const float* gain, bf16_t* WT, int k0, int n0, int drow0, LAS float* scr, int lane) {
    const int c = lane & 7;
    f32x4 ga = (f32x4){1.f, 1.f, 1.f, 1.f}, gb = ga;
    if (gain) { ga = *(const f32x4*)(gain + k0 + 8 * c); gb = *(const f32x4*)(gain + k0 + 8 * c + 4); }
#pragma unroll 16
    for (int i = 0; i < 32; ++i) { const int kk = 2 * i + (lane >> 5); scr[kk * 33 + (lane & 31)] = W[(size_t)(k0 + kk) * N + n0 + (lane & 31)]; }
    asm volatile("s_waitcnt lgkmcnt(0)" ::: "memory");
#pragma unroll
    for (int j = 0; j < 4; ++j) { const int n = (lane >> 3) + 8 * j; const LAS float* s = scr + (8 * c) * 33 + n;
        u32x4 o; o.x = cvt_pk_bf16(s[0 * 33] * ga.x, s[1 * 33] * ga.y); o.y = cvt_pk_bf16(s[2 * 33] * ga.z, s[3 * 33] * ga.w); o.z = cvt_pk_bf16(s[4 * 33] * gb.x, s[5 * 33] * gb.y); o.w = cvt_pk_bf16(s[6 * 33] * gb.z, s[7 * 33] * gb.w);
        *(u32x4*)(WT + (size_t)(drow0 + n) * K + k0 + 8 * c) = o; }
    asm volatile("s_waitcnt lgkmcnt(0)" ::: "memory");
}
__device__ __forceinline__ void p0_matrix_item(const float* W, int K, int N, const float* gain, bf16_t* WT, int mode, int item, LAS float* scr, int lane) {
    const int nblk = N / 32, kb = item / nblk, nb = item % nblk, n0 = 32 * nb;
    const int drow0 = mode == 0 ? n0 : ((n0 >> 7) * 256 + (n0 & 127) + (mode == 2 ? 128 : 0));
    p0_transpose_item(W, K, N, gain, WT, 64 * kb, n0, drow0, scr, lane);
}

constexpr int KIMG_PITCH = 144, KIMG_OFF = 0;
constexpr int VT_PITCH = 528, VT_OFF = 36864;
constexpr int VN_PITCH = 272, VN_OFF = 70656;
constexpr int RSV_OFF = 105472;
__device__ __forceinline__ int vt_addr(int d, int tp) { return VT_OFF + d * VT_PITCH + ((((tp) >> 2) ^ ((d) >> 3)) << 4) + ((tp) & 3) * 4; }
__device__ __forceinline__ int vn_addr(int d, int tp) { return VN_OFF + d * VN_PITCH + ((((tp) >> 2) ^ ((d) >> 3)) << 4) + ((tp) & 3) * 4; }

#define TR_WRITE8(ADDRF, ch0, tp, a, b) do { \
    const unsigned a_[4] = {(a).x, (a).y, (a).z, (a).w}, b_[4] = {(b).x, (b).y, (b).z, (b).w}; \
    _Pragma("unroll") for (int p_ = 0; p_ < 4; ++p_) { \
        *(LAS unsigned*)(lds + ADDRF((ch0) + 2 * p_, (tp))) = (a_[p_] & 0xffffu) | (b_[p_] << 16); \
        *(LAS unsigned*)(lds + ADDRF((ch0) + 2 * p_ + 1, (tp))) = (a_[p_] >> 16) | (b_[p_] & 0xffff0000u); } } while (0)

__device__ __forceinline__ void attn_qsub(LAS unsigned char* lds, int win, int kt_lo, int kt_hi, const bf16x8 q0, const bf16x8 q1, bf16_t* optr, float sink2, int fr, int fq) {
    f32x4 S[12];
#pragma unroll
    for (int kt = 0; kt < 12; ++kt) {
        if (kt >= kt_lo && kt < kt_hi) {
            const LAS unsigned char* kp = lds + KIMG_OFF + (win + kt * 16 + fr) * KIMG_PITCH + fq * 16;
            const bf16x8 a0 = *(const LAS bf16x8*)kp, a1 = *(const LAS bf16x8*)(kp + 64);
            f32x4 z = (f32x4){0.f, 0.f, 0.f, 0.f};
            z = __builtin_amdgcn_mfma_f32_16x16x32_bf16(a0, q0, z, 0, 0, 0);
            S[kt] = __builtin_amdgcn_mfma_f32_16x16x32_bf16(a1, q1, z, 0, 0, 0);
        } else S[kt] = (f32x4){-INFINITY, -INFINITY, -INFINITY, -INFINITY};
        if (kt & 1) __builtin_amdgcn_sched_barrier(0);
    }
    float mx = sink2;
#pragma unroll
    for (int kt = 0; kt < 12; ++kt) mx = fmaxf(fmaxf(mx, fmaxf(S[kt].x, S[kt].y)), fmaxf(S[kt].z, S[kt].w));
    mx = fmaxf(mx, __shfl_xor(mx, 16)); mx = fmaxf(mx, __shfl_xor(mx, 32));
    float l = 0.f;
#pragma unroll
    for (int kt = 0; kt < 12; ++kt) {
#pragma unroll
        for (int i = 0; i < 4; ++i) { const float p = __builtin_amdgcn_exp2f(S[kt][i] - mx); S[kt][i] = p; l += p; }
    }
    l += __shfl_xor(l, 16); l += __shfl_xor(l, 32);
    l += __builtin_amdgcn_exp2f(sink2 - mx);
    f32x4 O[4];
#pragma unroll
    for (int dt = 0; dt < 4; ++dt) O[dt] = (f32x4){0.f, 0.f, 0.f, 0.f};
#pragma unroll
    for (int s = 0; s < 6; ++s) {
        if (2 * s + 1 >= kt_lo && 2 * s < kt_hi) {
            u32x4 pw; pw.x = cvt_pk_bf16(S[2 * s].x, S[2 * s].y); pw.y = cvt_pk_bf16(S[2 * s].z, S[2 * s].w); pw.z = cvt_pk_bf16(S[2 * s + 1].x, S[2 * s + 1].y); pw.w = cvt_pk_bf16(S[2 * s + 1].z, S[2 * s + 1].w);
            const bf16x8 pf = __builtin_bit_cast(bf16x8, pw);
            const int tp = (win >> 1) + 16 * s + 2 * fq;
#pragma unroll
            for (int dt = 0; dt < 4; ++dt) {
                const int d = dt * 16 + fr;
                const u32x2 lo = *(const LAS u32x2*)(lds + vt_addr(d, tp)), hi = *(const LAS u32x2*)(lds + vt_addr(d, tp + 8));
                const u32x4 vv = (u32x4){lo.x, lo.y, hi.x, hi.y};
                O[dt] = __builtin_amdgcn_mfma_f32_16x16x32_bf16(__builtin_bit_cast(bf16x8, vv), pf, O[dt], 0, 0, 0);
            }
        }
        __builtin_amdgcn_sched_barrier(0);
    }
    const float rl = __builtin_amdgcn_rcpf(l);
#pragma unroll
    for (int dt = 0; dt < 4; ++dt) { u32x2 w; w.x = cvt_pk_bf16(O[dt].x * rl, O[dt].y * rl); w.y = cvt_pk_bf16(O[dt].z * rl, O[dt].w * rl); *(u32x2*)(optr + dt * 16) = w; }
}

struct MixArgs {
    bf16_t *U, *VG, *Q; const bf16_t* KV; const bf16_t* WM; const float* ssqv; const float* gmn; const float* gm_ws; const float* gm_bs; const float* sinks;
    const float* cache_k; const float* cache_v; float* gvout;
};

__device__ __forceinline__ void mix_prompt_unit(LAS unsigned char* lds, const MixArgs& A, int b, int cc) {
    const int tid = threadIdx.x, lane = tid & 63, wave = __builtin_amdgcn_readfirstlane(tid >> 6), fr = lane & 15, fq = lane >> 4;
    const int t0 = cc * 128; const size_t R0 = (size_t)b * SEQ + t0;
    LAS float* rsv = (LAS float*)(lds + RSV_OFF);
    __syncthreads();
    if (tid < 128) { const f32x4* p = (const f32x4*)(A.ssqv + (R0 + tid) * 16); const f32x4 a = p[0], b4 = p[1], c = p[2], d = p[3];
        const float s = ((a.x + a.y) + (a.z + a.w)) + ((b4.x + b4.y) + (b4.z + b4.w)) + ((c.x + c.y) + (c.z + c.w)) + ((d.x + d.y) + (d.z + d.w));
        rsv[tid] = rsqrtf(s * (1.0f / DM) + EPS); }
#ifndef MK_NOATT
    for (int kvh = 0; kvh < 2; ++kvh) {
        __syncthreads();
#pragma unroll
        for (int it = 0; it < 4; ++it) {
            const int idx = tid + it * NTHREADS, row = idx >> 3, ch = idx & 7, tok = t0 - 128 + row;
            u32x4 v = (u32x4){0u, 0u, 0u, 0u};
            if (tok >= 0) v = *(const u32x4*)(A.KV + ((size_t)b * SEQ + tok) * 256 + kvh * 64 + ch * 8);
            *(LAS u32x4*)(lds + KIMG_OFF + row * KIMG_PITCH + ch * 16) = v;
        }
#pragma unroll
        for (int it = 0; it < 2; ++it) {
            const int idx = tid + it * NTHREADS, tp = idx >> 3, ch = idx & 7, tok = t0 - 128 + 2 * tp;
            u32x4 va = (u32x4){0u, 0u, 0u, 0u}, vb = va;
            if (tok >= 0) { const bf16_t* p = A.KV + ((size_t)b * SEQ + tok) * 256 + 128 + kvh * 64 + ch * 8; va = *(const u32x4*)p; vb = *(const u32x4*)(p + 256); }
            TR_WRITE8(vt_addr, ch * 8, tp, va, vb);
        }
        __syncthreads();
        const int head = kvh * 8 + wave;
        const float sink2 = A.sinks[head] * LOG2E;
        const bf16_t* qbase = A.Q + (R0 + fr) * DM + head * 64 + 8 * fq;
        bf16x8 q0 = *(const bf16x8*)qbase, q1 = *(const bf16x8*)(qbase + 32);
#pragma unroll 1
        for (int qs = 0; qs < 8; ++qs) {
            const int qc = qs >> 2;
            const int kt_lo = (t0 == 0) ? 4 * (2 - qc) : 0;
            const size_t row = R0 + qs * 16 + fr;
            const bf16_t* qn = qbase + (size_t)(qs < 7 ? qs + 1 : qs) * 16 * DM;
            const bf16x8 n0 = *(const bf16x8*)qn, n1 = *(const bf16x8*)(qn + 32);
            attn_qsub(lds, qc * 64, kt_lo, 12, q0, q1, A.Q + row * DM + head * 64 + 4 * fq, sink2, fr, fq);
            q0 = n0; q1 = n1;
        }
    }
#endif
#ifndef MK_NOGMLP
#define VN2_ADDR(d_, tp_) ((d_) * 272 + (((((tp_)) >> 2) ^ ((d_) >> 3)) << 4) + ((tp_) & 3) * 4)
#pragma unroll 1
    for (int g = 0; g < 8; ++g) {
        __syncthreads();
#pragma unroll
        for (int it = 0; it < 2; ++it) {
            const int idx = tid + it * NTHREADS, tp = idx >> 4, ch = idx & 15;
            const bf16_t* p = A.VG + (R0 + 2 * tp) * DM + g * 128 + ch * 8;
            const u32x4 va = *(const u32x4*)p, vb = *(const u32x4*)(p + DM);
            const float ra = rsv[2 * tp], rb = rsv[2 * tp + 1];
            const f32x4 g0 = *(const f32x4*)(A.gmn + g * 128 + ch * 8), g1 = *(const f32x4*)(A.gmn + g * 128 + ch * 8 + 4);
            u32x4 sa, sb;
            sa.x = cvt_pk_bf16(bf_lo(va.x) * ra * g0.x, bf_hi(va.x) * ra * g0.y); sa.y = cvt_pk_bf16(bf_lo(va.y) * ra * g0.z, bf_hi(va.y) * ra * g0.w);
            sa.z = cvt_pk_bf16(bf_lo(va.z) * ra * g1.x, bf_hi(va.z) * ra * g1.y); sa.w = cvt_pk_bf16(bf_lo(va.w) * ra * g1.z, bf_hi(va.w) * ra * g1.w);
            sb.x = cvt_pk_bf16(bf_lo(vb.x) * rb * g0.x, bf_hi(vb.x) * rb * g0.y); sb.y = cvt_pk_bf16(bf_lo(vb.y) * rb * g0.z, bf_hi(vb.y) * rb * g0.w);
            sb.z = cvt_pk_bf16(bf_lo(vb.z) * rb * g1.x, bf_hi(vb.z) * rb * g1.y); sb.w = cvt_pk_bf16(bf_lo(vb.w) * rb * g1.z, bf_hi(vb.w) * rb * g1.w);
            TR_WRITE8(VN2_ADDR, ch * 8, tp, sa, sb);
        }
        __syncthreads();
#pragma unroll
        for (int ii = 0; ii < 2; ++ii) {
            const int it = ii == 0 ? wave : 7 - wave, ns = it < 4 ? 2 : 4;
            f32x4 acc[4];
#pragma unroll
            for (int ds = 0; ds < 4; ++ds) acc[ds] = (f32x4){0.f, 0.f, 0.f, 0.f};
            const float* wrow = A.gm_ws + ((size_t)(g * 128 + it * 16 + fr)) * 128 + 4 * fq;
#pragma unroll
            for (int sk = 0; sk < 4; ++sk) {
                if (sk < ns) {
                    const f32x4 wl = *(const f32x4*)(wrow + 32 * sk), wh = *(const f32x4*)(wrow + 32 * sk + 16);
                    const bf16x8 wfrag = __builtin_bit_cast(bf16x8, ((u32x4){cvt_pk_bf16(wl.x, wl.y), cvt_pk_bf16(wl.z, wl.w), cvt_pk_bf16(wh.x, wh.y), cvt_pk_bf16(wh.z, wh.w)}));
                    const int tp = 16 * sk + 2 * fq;
#pragma unroll
                    for (int ds = 0; ds < 4; ++ds) {
                        const int d = (ii * 4 + ds) * 16 + fr;
                        const u32x2 lo = *(const LAS u32x2*)(lds + VN2_ADDR(d, tp)), hi = *(const LAS u32x2*)(lds + VN2_ADDR(d, tp + 8));
                        const u32x4 vv = (u32x4){lo.x, lo.y, hi.x, hi.y};
                        acc[ds] = __builtin_amdgcn_mfma_f32_16x16x32_bf16(__builtin_bit_cast(bf16x8, vv), wfrag, acc[ds], 0, 0, 0);
                    }
                    __builtin_amdgcn_sched_barrier(0);
                }
            }
            const int itok = it * 16 + fr;
            const float bias = A.gm_bs[g * 128 + itok];
            bf16_t* up = A.U + (R0 + itok) * DM + g * 128 + ii * 64 + 4 * fq;
#pragma unroll
            for (int ds = 0; ds < 4; ++ds) {
                const u32x2 uu = *(const u32x2*)(up + ds * 16);
                u32x2 w; w.x = cvt_pk_bf16(bf_lo(uu.x) * (acc[ds].x + bias), bf_hi(uu.x) * (acc[ds].y + bias));
                w.y = cvt_pk_bf16(bf_lo(uu.y) * (acc[ds].z + bias), bf_hi(uu.y) * (acc[ds].w + bias));
                *(u32x2*)(up + ds * 16) = w;
            }
            __builtin_amdgcn_sched_barrier(0);
        }
    }
#undef VN2_ADDR
#endif
}

__device__ __forceinline__ u32x4 sample_kv8(const float* cache, const bf16_t* KV, int voff, int sb, int key, int kvh, int ch) {
    u32x4 v = (u32x4){0u, 0u, 0u, 0u};
    if (key < 128) { const float* p = cache + (((size_t)sb * 128 + key) * 2 + kvh) * 64 + ch * 8; const f32x4 a = *(const f32x4*)p, b = *(const f32x4*)(p + 4);
        v.x = cvt_pk_bf16(a.x, a.y); v.y = cvt_pk_bf16(a.z, a.w); v.z = cvt_pk_bf16(b.x, b.y); v.w = cvt_pk_bf16(b.z, b.w); }
    else if (key < 144) v = *(const u32x4*)(KV + ((size_t)NPROMPT + sb * 16 + (key - 128)) * 256 + voff + kvh * 64 + ch * 8);
    return v;
}

__device__ __forceinline__ void mix_sample_unit(LAS unsigned char* lds, const MixArgs& A, int sb) {
    const int tid = threadIdx.x, lane = tid & 63, wave = __builtin_amdgcn_readfirstlane(tid >> 6), fr = lane & 15, fq = lane >> 4;
    const size_t R0 = (size_t)NPROMPT + sb * 16;
    LAS float* rsv = (LAS float*)(lds + RSV_OFF);
    __syncthreads();
    if (tid < 16) { const f32x4* p = (const f32x4*)(A.ssqv + (R0 + tid) * 16); const f32x4 a = p[0], b4 = p[1], c = p[2], d = p[3];
        const float s = ((a.x + a.y) + (a.z + a.w)) + ((b4.x + b4.y) + (b4.z + b4.w)) + ((c.x + c.y) + (c.z + c.w)) + ((d.x + d.y) + (d.z + d.w));
        rsv[tid] = rsqrtf(s * (1.0f / DM) + EPS); }
    for (int kvh = 0; kvh < 2; ++kvh) {
        __syncthreads();
        for (int idx = tid; idx < 160 * 8; idx += NTHREADS) {
            const int row = idx >> 3, ch = idx & 7;
            *(LAS u32x4*)(lds + KIMG_OFF + row * KIMG_PITCH + ch * 16) = sample_kv8(A.cache_k, A.KV, 0, sb, row, kvh, ch);
        }
        for (int idx = tid; idx < 80 * 8; idx += NTHREADS) {
            const int tp = idx >> 3, ch = idx & 7;
            const u32x4 va = sample_kv8(A.cache_v, A.KV, 128, sb, 2 * tp, kvh, ch), vb = sample_kv8(A.cache_v, A.KV, 128, sb, 2 * tp + 1, kvh, ch);
            TR_WRITE8(vt_addr, ch * 8, tp, va, vb);
        }
        __syncthreads();
        const int head = kvh * 8 + wave;
        const float sink2 = A.sinks[head] * LOG2E;
        const size_t row = R0 + fr;
        { const bf16_t* qp = A.Q + row * DM + head * 64 + 8 * fq; const bf16x8 q0 = *(const bf16x8*)qp, q1 = *(const bf16x8*)(qp + 32);
          attn_qsub(lds, 0, 0, 9, q0, q1, A.Q + row * DM + head * 64 + 4 * fq, sink2, fr, fq); }
    }
    {
        const int c = 2 * tid, g = wave;
        float v0[16], v1[16];
        const f32x2 gm = *(const f32x2*)(A.gmn + c);
#pragma unroll
        for (int j = 0; j < 16; ++j) {
            const unsigned w = *(const unsigned*)(A.VG + (R0 + j) * DM + c); const float r = rsv[j];
            v0[j] = bf_lo(w) * r * gm.x; v1[j] = bf_hi(w) * r * gm.y;
            *(f32x2*)(A.gvout + ((size_t)sb * 16 + j) * DM + c) = (f32x2){v0[j], v1[j]};
        }
#pragma unroll 1
        for (int i = 0; i < 16; ++i) {
            const float bias = A.gm_bs[g * 128 + i]; float a0 = bias, a1 = bias;
            const float* wrow = A.gm_ws + ((size_t)g * 128 + i) * 128;
#pragma unroll
            for (int j = 0; j < 16; ++j) { const float w = wrow[j]; a0 += w * v0[j]; a1 += w * v1[j]; }
            unsigned* up = (unsigned*)(A.U + (R0 + i) * DM + c); const unsigned uu = *up;
            *up = cvt_pk_bf16(bf_lo(uu) * a0, bf_hi(uu) * a1);
        }
    }
}

#define XB_TMO      128
#define XB_XCNT(j)  (256  + 64 * (j))
#define XB_XSUB(j)  (1280 + 64 * (j))
#define XB_XGEN(j)  (2304 + 64 * (j))
#define XB_TOP      3328
#define XB_TOPGEN   3392
#define XCD_BAR_WORDS 3456
#define XB_SPIN_CAP (1u << 18)
__device__ __forceinline__ unsigned xb_ld(unsigned* p)              { return __hip_atomic_load(p, __ATOMIC_RELAXED, __HIP_MEMORY_SCOPE_AGENT); }
__device__ __forceinline__ unsigned xb_add(unsigned* p, unsigned v) { return __hip_atomic_fetch_add(p, v, __ATOMIC_RELAXED, __HIP_MEMORY_SCOPE_AGENT); }
__device__ __forceinline__ unsigned xb_xcc_id() { return (unsigned)__builtin_amdgcn_s_getreg((3 << 11) | 20) & 0xFu; }
#define XB_SPIN(cond, bar) do { unsigned _sp = 0; while (cond) { __builtin_amdgcn_s_sleep(1); \
    if ((++_sp & 255u) == 0u) { if (xb_ld(&(bar)[XB_TMO])) break; if (_sp > XB_SPIN_CAP) { atomicAdd(&(bar)[XB_TMO], 1u); break; } } } } while (0)
struct XcdBarrier { unsigned* bar; unsigned x; volatile LAS unsigned* st; };
__device__ __forceinline__ XcdBarrier xcd_barrier_post(unsigned* bar, volatile LAS unsigned* st) {
    XcdBarrier b; b.bar = bar; b.x = xb_xcc_id(); b.st = st;
    if (threadIdx.x == 0) (void)xb_add(&bar[XB_XCNT(b.x)], 1u);
    return b;
}
__device__ __forceinline__ void xcd_barrier_complete(unsigned* bar, unsigned x, unsigned& nloc, unsigned& nx) {
    const unsigned G = gridDim.x * gridDim.y * gridDim.z;
    unsigned sum, cnt, mine, sp = 0u;
    for (;;) {
        sum = 0u; cnt = 0u; mine = 0u;
#pragma unroll
        for (unsigned j = 0; j < 16; ++j) { const unsigned c = xb_ld(&bar[XB_XCNT(j)]); sum += c; cnt += (c > 0u) ? 1u : 0u; mine = (j == x) ? c : mine; }
        if (sum == G) break;
        __builtin_amdgcn_s_sleep(1);
        if ((++sp & 255u) == 0u) { if (xb_ld(&bar[XB_TMO])) break; if (sp > XB_SPIN_CAP) { atomicAdd(&bar[XB_TMO], 1u); break; } }
    }
    nloc = mine > 0u ? mine : 1u; nx = cnt > 0u ? cnt : 1u;
}
__device__ __forceinline__ void xcd_barrier(const XcdBarrier& b) {
    asm volatile("s_waitcnt vmcnt(0)" ::: "memory");
    __syncthreads();
    if (threadIdx.x == 0) {
        unsigned* bar = b.bar;
        __builtin_amdgcn_s_waitcnt(0);
        unsigned nloc = b.st[0], nx = b.st[1];
        if (nloc == 0u) { xcd_barrier_complete(bar, b.x, nloc, nx); b.st[0] = nloc; b.st[1] = nx; }
        const unsigned old = xb_add(&bar[XB_XSUB(b.x)], 1u);
        const unsigned gen = old / nloc;
        if (old + 1u == (gen + 1u) * nloc) {
            __builtin_amdgcn_fence(__ATOMIC_RELEASE, "agent");
            asm volatile("s_waitcnt vmcnt(0)" ::: "memory");
            const unsigned og = xb_add(&bar[XB_TOP], 1u);
            const unsigned tg = og / nx;
            if (og + 1u == (tg + 1u) * nx) xb_add(&bar[XB_TOPGEN], 1u);
            else XB_SPIN(xb_ld(&bar[XB_TOPGEN]) == tg, bar);
            __builtin_amdgcn_fence(__ATOMIC_ACQUIRE, "agent");
            xb_add(&bar[XB_XGEN(b.x)], 1u);
            asm volatile("s_waitcnt vmcnt(0)" ::: "memory");
        } else {
            XB_SPIN(xb_ld(&bar[XB_XGEN(b.x)]) == gen, bar);
            __builtin_amdgcn_fence(__ATOMIC_ACQUIRE, "agent");
            asm volatile("s_waitcnt vmcnt(0)" ::: "memory");
        }
    }
    __syncthreads();
}

struct Args { const float* in[22]; float* out; unsigned char* ws; int ph_lo, ph_hi; };
constexpr int NPHASE = 10;

__global__ void __launch_bounds__(NTHREADS, 2) mk_fwd(Args args) {
    extern __shared__ __attribute__((aligned(16))) unsigned char lds_raw[];
    LAS unsigned char* lds = (LAS unsigned char*)lds_raw;
    const int tid = threadIdx.x, lane = tid & 63, wave = __builtin_amdgcn_readfirstlane(tid >> 6);
    const int G = gridDim.x, bx = blockIdx.x;
    unsigned char* ws = args.ws;
    const float* x_prompt = args.in[0]; const float* x_sample = args.in[1];
    float* out = args.out;
    bf16_t* W13_1 = (bf16_t*)(ws + WS_W13_1); bf16_t* W2_1 = (bf16_t*)(ws + WS_W2_1); bf16_t* WIN = (bf16_t*)(ws + WS_WIN); bf16_t* WPA = (bf16_t*)(ws + WS_WPA); bf16_t* WPB = (bf16_t*)(ws + WS_WPB);
    bf16_t* WOUT = (bf16_t*)(ws + WS_WOUT); bf16_t* W13_2 = (bf16_t*)(ws + WS_W13_2); bf16_t* W2_2 = (bf16_t*)(ws + WS_W2_2); bf16_t* WM = (bf16_t*)(ws + WS_WM);
    float* SSQ0 = (float*)(ws + WS_SSQ0); float* SSQ1 = (float*)(ws + WS_SSQ1); float* SSQ2 = (float*)(ws + WS_SSQ2); float* SSQ3 = (float*)(ws + WS_SSQ3); float* SSQV = (float*)(ws + WS_SSQV);
    bf16_t* XB = (bf16_t*)(ws + WS_XB); bf16_t* KV = (bf16_t*)(ws + WS_KV); bf16_t* ACT = (bf16_t*)(ws + WS_ACT); bf16_t* U = (bf16_t*)(ws + WS_U); bf16_t* VG = (bf16_t*)(ws + WS_VG);
    bf16_t* Q = (bf16_t*)(ws + WS_Q); bf16_t* GT = (bf16_t*)(ws + WS_G); bf16_t* MB = VG;
    const int lo = args.ph_lo, hi = args.ph_hi;
    asm volatile("buffer_inv sc1\n\ts_waitcnt vmcnt(0)" ::: "memory");
    volatile LAS unsigned* xst = (volatile LAS unsigned*)(lds + LDS_BYTES - 16);
    if (tid == 0) { xst[0] = 0u; xst[1] = 0u; }
    __syncthreads();
    XcdBarrier xbar; xbar.bar = (unsigned*)ws; xbar.x = 0; xbar.st = xst;
    if (hi - lo > 1) xbar = xcd_barrier_post((unsigned*)ws, xst);
#ifndef MK_MASK
#define MK_MASK 0x7ff
#endif
#define IN(k) (((MK_MASK >> (k)) & 1) && lo <= (k) && (k) < hi)
#define SEAM(k) do { if (lo <= (k) && (k) + 1 < hi) { \
        if ((k) == 0) { \
            asm volatile("s_waitcnt vmcnt(0) lgkmcnt(0)" ::: "memory"); __syncthreads(); \
            if (wave == 0) asm volatile("buffer_wbl2 sc1\n\ts_waitcnt vmcnt(0)" ::: "memory"); \
            cg::this_grid().sync();                                                                \
            if (wave == 0) asm volatile("buffer_inv sc1\n\ts_waitcnt vmcnt(0)" ::: "memory"); \
            __syncthreads(); \
        } else { xcd_barrier(xbar); } \
    } } while (0)

    if (IN(0)) {
#ifndef PROBE_REP0
#define PROBE_REP0 1
#endif
      for (int rep_ = 0; rep_ < PROBE_REP0; ++rep_) {
        const int gw = bx * NWAVES + wave, NGW = G * NWAVES;
        for (int r = gw; r < MP; r += NGW) {
            u32x2* o8 = (u32x2*)(XB + (size_t)r * DM) + lane;
            float s = 0.f;
            if (r < MREAL) {
                const float* xr = r < NPROMPT ? x_prompt + (size_t)r * DM : x_sample + (size_t)(r - NPROMPT) * DM;
#pragma unroll
                for (int j = 0; j < 4; ++j) { const f32x4 v = *((const f32x4*)xr + lane + 64 * j); s += (v.x * v.x + v.y * v.y) + (v.z * v.z + v.w * v.w);
                    u32x2 w; w.x = cvt_pk_bf16(v.x, v.y); w.y = cvt_pk_bf16(v.z, v.w); o8[64 * j] = w; }
            } else {
#pragma unroll
                for (int j = 0; j < 4; ++j) o8[64 * j] = (u32x2){0u, 0u};
            }
            s = wave_sum(s);
            if (lane < 16) { SSQ0[(size_t)r * 16 + lane] = lane == 0 ? s : 0.f; if (r >= NPROMPT) { SSQ1[(size_t)r * 16 + lane] = 0.f; SSQ2[(size_t)r * 16 + lane] = 0.f; SSQ3[(size_t)r * 16 + lane] = 0.f; } }
        }
        for (int e = (bx * NTHREADS + tid) * 4; e < 8 * 128 * 128; e += G * NTHREADS * 4) {
            const f32x4 v = *(const f32x4*)(args.in[11] + e); const int i = (e >> 7) & 127, j = e & 127;
            const bool keepv = (i >> 6) >= (j >> 6);
            u32x2 w; w.x = keepv ? cvt_pk_bf16(v.x, v.y) : 0u; w.y = keepv ? cvt_pk_bf16(v.z, v.w) : 0u;
            *(u32x2*)(WM + e) = w;
        }
        LAS float* scr = (LAS float*)(lds + wave * 16384);
        constexpr int I_UP = (DM / 64) * (DFF / 32), I_DN = (DFF / 64) * (DM / 32), I_IN = (DM / 64) * (NIN / 32), I_SQ = (DM / 64) * (DM / 32);
        constexpr int NITEMS = 4 * I_UP + 2 * I_DN + I_IN + 3 * I_SQ;
        for (int it = gw; it < NITEMS; it += NGW) {
            int r = it;
            if (r < I_UP) { p0_matrix_item(args.in[5], DM, DFF, args.in[4], W13_1, 1, r, scr, lane); continue; } r -= I_UP;
            if (r < I_UP) { p0_matrix_item(args.in[6], DM, DFF, args.in[4], W13_1, 2, r, scr, lane); continue; } r -= I_UP;
            if (r < I_DN) { p0_matrix_item(args.in[7], DFF, DM, nullptr, W2_1, 0, r, scr, lane); continue; } r -= I_DN;
            if (r < I_IN) { p0_matrix_item(args.in[9], DM, NIN, args.in[8], WIN, 0, r, scr, lane); continue; } r -= I_IN;
            if (r < I_SQ) { p0_matrix_item(args.in[14], DM, DM, nullptr, WPA, 0, r, scr, lane); continue; } r -= I_SQ;
            if (r < I_SQ) { p0_matrix_item(args.in[15], DM, DM, nullptr, WPB, 0, r, scr, lane); continue; } r -= I_SQ;
            if (r < I_SQ) { p0_matrix_item(args.in[16], DM, DM, nullptr, WOUT, 0, r, scr, lane); continue; } r -= I_SQ;
            if (r < I_UP) { p0_matrix_item(args.in[18], DM, DFF, args.in[17], W13_2, 1, r, scr, lane); continue; } r -= I_UP;
            if (r < I_UP) { p0_matrix_item(args.in[19], DM, DFF, args.in[17], W13_2, 2, r, scr, lane); continue; } r -= I_UP;
            p0_matrix_item(args.in[20], DFF, DM, nullptr, W2_2, 0, r, scr, lane);
        }
        asm volatile("s_waitcnt vmcnt(0) lgkmcnt(0)" ::: "memory"); __syncthreads();
      }
    }
    SEAM(0);
    if (IN(1)) {
        for (int jj = G - 1 - bx; jj < 352; jj += G) sample_up(lds, XB + (size_t)NPROMPT * DM, W13_1, SSQ0, ACT, jj, wave, lane);
        pg8::Gemm g{XB, W13_1, DM, 0, 0}; pg8::StaticOrder S; S.init(NPROMPT, NUP, G, bx, 0);
        pg8::EpiSwiglu E{ACT, SSQ0};
        pg8::gemm_phase(lds, g, S, E);
    }
    SEAM(1);
    if (IN(2)) {
        if (bx >= G - 128) { SkResid F{x_sample - (size_t)NPROMPT * DM, out, XB, SSQ1, 0.5f}; sample_gemm(lds, ACT + (size_t)NPROMPT * DFF, W2_1, DFF, G - 1 - bx, wave, lane, F); }
        pg8::Gemm g{ACT, W2_1, DFF, 0, 0}; pg8::StaticOrder S; S.init(NPROMPT, DM, G, bx, 0);
        pg8::EpiResid E{x_prompt, x_sample, out, XB, SSQ1, 0.5f, 0};
        pg8::gemm_phase(lds, g, S, E);
    }
    SEAM(2);
    if (IN(3)) {
        pg8::Gemm g{XB, WIN, DM, 0, 0}; pg8::StaticOrder S; S.init(MP, NIN, G, bx, 0);
        pg8::EpiWin E{U, VG, Q, KV, GT, SSQ1, SSQV, out};
        pg8::gemm_phase(lds, g, S, E);
    }
    SEAM(3);
    if (IN(4)) {
        MixArgs A{U, VG, Q, KV, WM, SSQV, args.in[10], args.in[11], args.in[12], args.in[13], args.in[2], args.in[3], out + OFF_GV};
#pragma unroll 1
        for (int v = bx; v < 256; v += G) mix_prompt_unit(lds, A, v >> 6, v & 63);
        __builtin_amdgcn_sched_barrier(0);
#pragma unroll 1
        for (int v = G - 1 - bx; v < 8; v += G) mix_sample_unit(lds, A, v);
        asm volatile("s_waitcnt vmcnt(0) lgkmcnt(0)" ::: "memory"); __syncthreads();
    }
    SEAM(4);
    if (IN(5)) {
        {
            if (bx >= G - 128) { SkGate F{GT, MB, 0}; sample_gemm(lds, U + (size_t)NPROMPT * DM, WPA, DM, G - 1 - bx, wave, lane, F); }
            pg8::Gemm g{U, WPA, DM, 0, 0}; pg8::StaticOrder S; S.init(NPROMPT, DM, G, bx, 0);
            pg8::EpiGate E{GT, MB, 0};
            pg8::gemm_phase(lds, g, S, E);
        }
        {
            if (bx >= G - 128) { SkGate F{GT, MB, 1}; sample_gemm(lds, Q + (size_t)NPROMPT * DM, WPB, DM, G - 1 - bx, wave, lane, F); }
            pg8::Gemm g{Q, WPB, DM, 0, 0}; pg8::StaticOrder S; S.init(NPROMPT, DM, G, bx, 0);
            pg8::EpiGate E{GT, MB, 1};
            pg8::gemm_phase(lds, g, S, E);
        }
    }
    SEAM(5);
    if (IN(6)) {
        if (bx >= G - 128) { SkResid F{out, out, XB, SSQ2, 1.0f}; sample_gemm(lds, MB + (size_t)NPROMPT * DM, WOUT, DM, G - 1 - bx, wave, lane, F); }
        pg8::Gemm g{MB, WOUT, DM, 0, 0}; pg8::StaticOrder S; S.init(NPROMPT, DM, G, bx, 0);
        pg8::EpiResid E{x_prompt, x_sample, out, XB, SSQ2, 1.0f, 1};
        pg8::gemm_phase(lds, g, S, E);
    }
    SEAM(6);
    if (IN(7)) {
        for (int jj = G - 1 - bx; jj < 352; jj += G) sample_up(lds, XB + (size_t)NPROMPT * DM, W13_2, SSQ2, ACT, jj, wave, lane);
        pg8::Gemm g{XB, W13_2, DM, 0, 0}; pg8::StaticOrder S; S.init(NPROMPT, NUP, G, bx, 0);
        pg8::EpiSwiglu E{ACT, SSQ2};
        pg8::gemm_phase(lds, g, S, E);
    }
    SEAM(7);
    if (IN(8)) {
        if (bx >= G - 128) { SkResid F{out, out, nullptr, SSQ3, 0.5f}; sample_gemm(lds, ACT + (size_t)NPROMPT * DFF, W2_2, DFF, G - 1 - bx, wave, lane, F); }
        pg8::Gemm g{ACT, W2_2, DFF, 0, 0}; pg8::StaticOrder S; S.init(NPROMPT, DM, G, bx, 0);
        pg8::EpiResid E{x_prompt, x_sample, out, nullptr, SSQ3, 0.5f, 1};
        pg8::gemm_phase(lds, g, S, E);
    }
    SEAM(8);
    if (IN(9)) {
        const int gw = bx * NWAVES + wave, NGW = G * NWAVES;
        const float* nf = args.in[21];
        f32x4 gn[4];
#pragma unroll
        for (int j = 0; j < 4; ++j) gn[j] = *((const f32x4*)nf + lane + 64 * j);
        for (int r = gw; r < MREAL; r += NGW) {
            const f32x4* sp = (const f32x4*)(SSQ3 + (size_t)r * 16); const f32x4 a = sp[0], b4 = sp[1], c = sp[2], d = sp[3];
            const float s = ((a.x + a.y) + (a.z + a.w)) + ((b4.x + b4.y) + (b4.z + b4.w)) + ((c.x + c.y) + (c.z + c.w)) + ((d.x + d.y) + (d.z + d.w));
            const float rs = rsqrtf(s * (1.0f / DM) + EPS);
            f32x4* xr = (f32x4*)(out + (size_t)r * DM) + lane;
#pragma unroll
            for (int j = 0; j < 4; ++j) { const f32x4 v = xr[64 * j]; xr[64 * j] = v * rs * gn[j]; }
        }
    }
    asm volatile("s_waitcnt vmcnt(0) lgkmcnt(0)\n\tbuffer_wbl2 sc1\n\ts_waitcnt vmcnt(0)" ::: "memory");
#undef IN
#undef SEAM
}

extern "C" void kernel_launch(void* const* d_in, const int* in_sizes, int n_in, void* d_out, int out_size, void* d_ws, size_t ws_size, hipStream_t stream) {
    static int grid = 0;
    if (grid == 0) {
        if (n_in != 22 || ws_size < WS_END) { fprintf(stderr, "kernel_launch: unexpected n_in %d / ws_size %zu (need %zu)\n", n_in, ws_size, (size_t)WS_END); grid = -1; return; }
        int dev = 0, cus = 0, per_cu = 0;
        hipGetDevice(&dev); hipDeviceGetAttribute(&cus, hipDeviceAttributeMultiprocessorCount, dev);
        if (hipFuncSetAttribute((const void*)mk_fwd, hipFuncAttributeMaxDynamicSharedMemorySize, LDS_BYTES) != hipSuccess) { fprintf(stderr, "kernel_launch: hipFuncSetAttribute failed\n"); grid = -1; return; }
        if (hipOccupancyMaxActiveBlocksPerMultiprocessor(&per_cu, (const void*)mk_fwd, NTHREADS, LDS_BYTES) != hipSuccess || per_cu < 1) { fprintf(stderr, "kernel_launch: occupancy query says %d\n", per_cu); (void)hipGetLastError(); grid = -1; return; }
        grid = cus;
    }
    if (grid < 0) return;
    Args a{};
    for (int i = 0; i < 22; ++i) a.in[i] = (const float*)d_in[i];
    a.out = (float*)d_out; a.ws = (unsigned char*)d_ws;
#if MK_MULTI
    { const int order[11] = {0, 1, 2, 3, 4, 5, 10, 6, 7, 8, 9};
      for (int q = 0; q < 11; ++q) { const int p = order[q]; a.ph_lo = p; a.ph_hi = p + 1; hipLaunchKernelGGL(mk_fwd, dim3(grid), dim3(NTHREADS), LDS_BYTES, stream, a); } }
#else
    a.ph_lo = 0; a.ph_hi = NPHASE;
    if (hipMemsetAsync(d_ws, 0, XCD_BAR_WORDS * 4, stream) != hipSuccess) { fprintf(stderr, "kernel_launch: memset of the barrier words failed\n"); return; }
    void* kargs[] = {&a};
    hipError_t e = hipLaunchCooperativeKernel((const void*)mk_fwd, dim3(grid), dim3(NTHREADS), kargs, LDS_BYTES, stream);
    if (e != hipSuccess) fprintf(stderr, "kernel_launch: cooperative launch failed: %s (grid %d)\n", hipGetErrorString(e), grid);
#endif
}
```

```cpp
#include <hip/hip_runtime.h>
#include <hip/hip_cooperative_groups.h>
#include <cstdio>
#include <cstdint>
namespace cg = cooperative_groups;


#ifndef MK_MULTI
#define MK_MULTI 0
#endif

#define GAS __attribute__((address_space(1)))
#define LAS __attribute__((address_space(3)))
typedef unsigned short bf16_t;
typedef short bf16x8 __attribute__((ext_vector_type(8)));
typedef float f32x4 __attribute__((ext_vector_type(4)));
typedef float f32x2 __attribute__((ext_vector_type(2)));
typedef unsigned u32x4 __attribute__((ext_vector_type(4)));
typedef unsigned u32x2 __attribute__((ext_vector_type(2)));

constexpr int DM = 1024, SEQ = 8192, NBATCH = 4, NPROMPT = NBATCH * SEQ, NSAMP = 128, MREAL = NPROMPT + NSAMP, MP = 33024  ;
constexpr int DFF = 2816, NUP = 2 * DFF, NIN = 5376;
constexpr float EPS = 1e-6f;
constexpr float LOG2E = 1.4426950408889634f;
constexpr float QSCALE = 0.125f * LOG2E;
constexpr int NWAVES = 8, NTHREADS = 512;
constexpr size_t OFF_YS = (size_t)NPROMPT * DM, OFF_KP = OFF_YS + (size_t)NSAMP * DM, OFF_VP = OFF_KP + 65536, OFF_KS = OFF_VP + 65536, OFF_VS = OFF_KS + 16384, OFF_GV = OFF_VS + 16384;
constexpr size_t MiB = 1u << 20;
constexpr size_t WS_W13_1 = 1 * MiB, WS_W2_1 = 12 * MiB, WS_WIN = 18 * MiB, WS_WPA = 29 * MiB, WS_WPB = 31 * MiB, WS_WOUT = 33 * MiB, WS_W13_2 = 35 * MiB, WS_W2_2 = 46 * MiB, WS_WM = 52 * MiB;
constexpr size_t WS_SSQ0 = 53 * MiB, WS_SSQ1 = 56 * MiB, WS_SSQ2 = 59 * MiB, WS_SSQ3 = 62 * MiB, WS_SSQV = 65 * MiB;
constexpr size_t WS_XB = 68 * MiB, WS_KV = 133 * MiB, WS_ACT = 150 * MiB, WS_G = 150 * MiB, WS_U = 280 * MiB, WS_VG = 345 * MiB, WS_Q = 410 * MiB, WS_END = 475 * MiB;
static_assert(WS_G + (size_t)MP * 2048 * 2 <= WS_U && WS_U + (size_t)MP * DM * 2 <= WS_VG && WS_VG + (size_t)MP * DM * 2 <= WS_Q && WS_Q + (size_t)MP * DM * 2 <= WS_END && WS_ACT + (size_t)MP * DFF * 2 <= WS_VG, "ws map");
static_assert(WS_SSQ0 + (size_t)MP * 64 <= WS_SSQ1 && WS_W13_1 + (size_t)NUP * DM * 2 <= WS_W2_1 && WS_W2_1 + (size_t)DM * DFF * 2 <= WS_WIN && WS_WIN + (size_t)NIN * DM * 2 <= WS_WPA && WS_W2_2 + (size_t)DM * DFF * 2 <= WS_WM, "ws map 2");
constexpr int LDS_BYTES = 147456;

__device__ __forceinline__ unsigned cvt_pk_bf16(float lo, float hi) { unsigned r; asm volatile("v_cvt_pk_bf16_f32 %0, %1, %2" : "=v"(r) : "v"(lo), "v"(hi)); return r; }
__device__ __forceinline__ float bf_lo(unsigned w) { return __uint_as_float(w << 16); }
__device__ __forceinline__ float bf_hi(unsigned w) { return __uint_as_float(w & 0xffff0000u); }
__device__ __forceinline__ float fast_sigmoid(float x) { return __builtin_amdgcn_rcpf(1.0f + __builtin_amdgcn_exp2f(-LOG2E * x)); }
__device__ __forceinline__ float silu_f(float x) { return x * fast_sigmoid(x); }
__device__ __forceinline__ float gelu_tanh(float x) { const float z = 1.5957691216057308f * (x + 0.044715f * x * x * x); return x * fast_sigmoid(z); }
__device__ __forceinline__ float wave_sum(float v) {
#pragma unroll
    for (int o = 1; o < 64; o <<= 1) v += __shfl_xor(v, o);
    return v;
}
__device__ __forceinline__ float row_rstd(const float* ssq, int row, int fq) {
    const f32x4 p = *(const f32x4*)(ssq + (size_t)row * 16 + 4 * fq);
    float s = (p.x + p.y) + (p.z + p.w);
    s += __shfl_xor(s, 16); s += __shfl_xor(s, 32);
    return rsqrtf(s * (1.0f / DM) + EPS);
}

__device__ __forceinline__ void rows_rstd8(const float* ssq, int row0, int fq, float (&rs)[8]) {
    f32x4 p[8];
#pragma unroll
    for (int t = 0; t < 8; ++t) p[t] = *(const f32x4*)(ssq + (size_t)(row0 + (t >> 2) * 128 + (t & 3) * 16) * 16 + 4 * fq);
    __builtin_amdgcn_sched_barrier(0);
#pragma unroll
    for (int t = 0; t < 8; ++t) { float s = (p[t].x + p[t].y) + (p[t].z + p[t].w); s += __shfl_xor(s, 16); s += __shfl_xor(s, 32); rs[t] = rsqrtf(s * (1.0f / DM) + EPS); }
}

namespace pg8 {
constexpr int BM = 256, BK = 64, HALF = 128, HTB = HALF * BK * 2, STAGE_BYTES = 8 * HTB, NXCD = 8, WGM = 8;
__host__ __device__ __forceinline__ int lds_byte(int r, int c) { const int st = (r >> 4) * 2 + (c >> 5), rr = r & 15, cc = c & 31, ob = rr * 64 + cc * 2; return st * 1024 + (ob ^ (((ob >> 9) & 1) << 5)); }
__host__ __device__ __forceinline__ void stage_rc(int b, int& R, int& C) { const int st = b / 1024, sb = b % 1024, swz = sb ^ (((sb >> 9) & 1) << 5); R = (st >> 1) * 16 + swz / 64; C = (st & 1) * 32 + (swz % 64) / 2; }
__host__ __device__ __forceinline__ int perm32(int rho) { const int n = rho >> 4, i = rho & 15; return 8 * (i >> 2) + 4 * n + (i & 3); }

struct Unit { int pm, pn, sel; };
struct Gemm { const bf16_t* A; const bf16_t* Bt; int K; size_t selA, selB; };

struct StaticOrder {
    int nM, nN, nwg, G, c, chain;
    __device__ void init(int M, int N, int G_, int c_, int chain_) { nM = M / BM; nN = N / BM; nwg = nM * nN; G = G_; c = c_; chain = chain_; }
    __device__ bool next(int i, Unit& u) const {
        const int ii = chain ? (i >> 1) : i;
        const long L = (long)ii * G + c; if (L >= nwg) return false;
        int wgid = (int)L; { const int q = nwg / NXCD, r = nwg % NXCD, xcd = wgid % NXCD, off = wgid / NXCD; wgid = (xcd < r ? xcd * (q + 1) : r * (q + 1) + (xcd - r) * q) + off; }
        const int nig = WGM * nN, gid = wgid / nig, fm = gid * WGM, gsz = (nM - fm) < WGM ? (nM - fm) : WGM;
        u.pm = fm + ((wgid % nig) % gsz); u.pn = (wgid % nig) / gsz; u.sel = chain ? (i & 1) : 0; return true;
    }
};

template <class Epi>
__device__ __forceinline__ void gemm_phase(LAS unsigned char* lds, const Gemm g, const StaticOrder& S, const Epi& E) {
    const int tid = threadIdx.x, wid = __builtin_amdgcn_readfirstlane(tid >> 6), lane = tid & 63, wr = wid >> 2, wc = wid & 3, fr = lane & 15, fq = lane >> 4;
    const int K = g.K, nt = K / BK;
    unsigned voffA[2], voffB[2];
#pragma unroll
    for (int i = 0; i < 2; ++i) { int R, C; stage_rc(tid * 16 + i * 8192, R, C); const int Rb = (R & ~31) + perm32(R & 31);
        voffA[i] = (unsigned)(R * K + C) * 2u; voffB[i] = (unsigned)(Rb * K + C) * 2u; }
    const size_t kstep = (size_t)(BK * 2);
    const size_t hstep = (size_t)HALF * K * 2;
    const size_t tstep = 2 * hstep;
    const unsigned ldsw = (unsigned)wid * 1024u;
    const int aoff = lds_byte(wr * 64 + fr, fq * 8), boff = lds_byte(wc * 32 + fr, fq * 8);
#define PG8_SA(b, h) (((b) * 2 + (h)) * HTB)
#define PG8_SB(b, h) ((4 + (b) * 2 + (h)) * HTB)
#define PG8_STAGE(bufoff, gbase, voff) do { _Pragma("unroll") for (int _i = 0; _i < 2; ++_i) \
        __builtin_amdgcn_global_load_lds((const unsigned*)((const char*)(gbase) + (voff)[_i]), (LAS unsigned*)(lds + (bufoff) + ldsw + _i * 8192), 16, 0, 0); } while (0)
#define PG8_LDA(dst, b, h) do { _Pragma("unroll") for (int m = 0; m < 4; ++m) _Pragma("unroll") for (int k = 0; k < 2; ++k) dst[m][k] = *(const LAS bf16x8*)(lds + PG8_SA(b, h) + aoff + m * 2048 + k * 1024); } while (0)
#define PG8_LDB(dst, b, h) do { _Pragma("unroll") for (int n = 0; n < 2; ++n) _Pragma("unroll") for (int k = 0; k < 2; ++k) dst[n][k] = *(const LAS bf16x8*)(lds + PG8_SB(b, h) + boff + n * 2048 + k * 1024); } while (0)
#define PG8_MMA(ai, bj, At, Bt) do { __builtin_amdgcn_s_setprio(1); _Pragma("unroll") for (int m = 0; m < 4; ++m) _Pragma("unroll") for (int n = 0; n < 2; ++n) _Pragma("unroll") for (int k = 0; k < 2; ++k) \
        acc[ai][bj][m][n] = __builtin_amdgcn_mfma_f32_16x16x32_bf16(Bt[n][k], At[m][k], acc[ai][bj][m][n], 0, 0, 0); __builtin_amdgcn_s_setprio(0); } while (0)
#define PG8_WAIT_V(n) asm volatile("s_waitcnt vmcnt(" #n ")" ::: "memory")
#define PG8_WAIT_L(n) asm volatile("s_waitcnt lgkmcnt(" #n ")" ::: "memory")
#define PG8_BAR __builtin_amdgcn_s_barrier()
#define PG8_SCHED __builtin_amdgcn_sched_barrier(0)
    Unit cur, nxt; int ui = 0;
    if (!S.next(0, cur)) return;
    f32x4 acc[2][2][4][2];
#pragma unroll
    for (int a = 0; a < 2; ++a)
#pragma unroll
        for (int b = 0; b < 2; ++b)
#pragma unroll
            for (int m = 0; m < 4; ++m)
#pragma unroll
                for (int n = 0; n < 2; ++n) acc[a][b][m][n] = (f32x4){0.f, 0.f, 0.f, 0.f};
    bf16x8 At[4][2], B0[2][2], B1[2][2];
    const char* cA = (const char*)g.A + (size_t)cur.pm * tstep + (size_t)cur.sel * g.selA; const char* cB = (const char*)g.Bt + (size_t)cur.pn * tstep + (size_t)cur.sel * g.selB;
    PG8_STAGE(PG8_SB(0, 0), cB, voffB); PG8_STAGE(PG8_SB(0, 1), cB + hstep, voffB); PG8_STAGE(PG8_SA(0, 0), cA, voffA); PG8_STAGE(PG8_SA(0, 1), cA + hstep, voffA);
    if (wr == 1) PG8_BAR;
    PG8_WAIT_V(2); PG8_BAR;
    PG8_STAGE(PG8_SB(1, 0), cB + kstep, voffB); PG8_STAGE(PG8_SA(1, 0), cA + kstep, voffA); PG8_STAGE(PG8_SB(1, 1), cB + hstep + kstep, voffB);
    PG8_WAIT_V(6); PG8_BAR;
    for (;;) {
        const bool has_next = S.next(ui + 1, nxt);
        const char* nA = has_next ? (const char*)g.A + (size_t)nxt.pm * tstep + (size_t)nxt.sel * g.selA : cA;
        const char* nB = has_next ? (const char*)g.Bt + (size_t)nxt.pn * tstep + (size_t)nxt.sel * g.selB : cB;
        for (int t = 0; t < nt; t += 2) {
            const bool last = (t == nt - 2);
            const char* a1 = cA + (size_t)(t + 1) * kstep;
            const char* a2 = last ? nA : cA + (size_t)(t + 2) * kstep; const char* b2 = last ? nB : cB + (size_t)(t + 2) * kstep;
            const char* a3 = a2 + kstep; const char* b3 = b2 + kstep;
            PG8_LDB(B0, 0, 0); PG8_LDB(B1, 0, 1); PG8_SCHED; PG8_LDA(At, 0, 0); PG8_STAGE(PG8_SA(1, 1), a1 + hstep, voffA);
            PG8_WAIT_V(8); PG8_WAIT_L(0); PG8_BAR; PG8_MMA(0, 0, At, B0); PG8_MMA(0, 1, At, B1); PG8_BAR; PG8_SCHED;
            PG8_LDA(At, 0, 1); PG8_STAGE(PG8_SB(0, 0), b2, voffB); PG8_STAGE(PG8_SB(0, 1), b2 + hstep, voffB); PG8_STAGE(PG8_SA(0, 0), a2, voffA);
            PG8_WAIT_V(8); PG8_WAIT_L(0); PG8_BAR; PG8_MMA(1, 0, At, B0); PG8_MMA(1, 1, At, B1); PG8_BAR; PG8_SCHED;
            PG8_LDB(B0, 1, 0); PG8_LDB(B1, 1, 1); PG8_SCHED; PG8_LDA(At, 1, 0); PG8_STAGE(PG8_SA(0, 1), a2 + hstep, voffA);
            PG8_WAIT_V(8); PG8_WAIT_L(0); PG8_BAR; PG8_MMA(0, 0, At, B0); PG8_MMA(0, 1, At, B1); PG8_BAR; PG8_SCHED;
            PG8_LDA(At, 1, 1); PG8_STAGE(PG8_SB(1, 0), b3, voffB); PG8_STAGE(PG8_SB(1, 1), b3 + hstep, voffB); PG8_STAGE(PG8_SA(1, 0), a3, voffA);
            PG8_WAIT_V(8); PG8_WAIT_L(0); PG8_BAR; PG8_MMA(1, 0, At, B0); PG8_MMA(1, 1, At, B1); PG8_BAR; PG8_SCHED;
        }
        if (wr == 0) PG8_BAR;
        E(acc, cur, wr, wc, fr, fq);
        if (!has_next) break;
        if (!E.keep(cur)) {
#pragma unroll
            for (int a = 0; a < 2; ++a)
#pragma unroll
                for (int b = 0; b < 2; ++b)
#pragma unroll
                    for (int m = 0; m < 4; ++m)
#pragma unroll
                        for (int n = 0; n < 2; ++n) acc[a][b][m][n] = (f32x4){0.f, 0.f, 0.f, 0.f};
        }
        cur = nxt; cA = nA; cB = nB; ++ui;
        if (wr == 1) PG8_BAR;
    }
    PG8_WAIT_V(0);
    PG8_BAR;
#undef PG8_SA
#undef PG8_SB
#undef PG8_STAGE
#undef PG8_LDA
#undef PG8_LDB
#undef PG8_MMA
#undef PG8_WAIT_V
#undef PG8_WAIT_L
#undef PG8_BAR
#undef PG8_SCHED
}

struct EpiSwiglu {
    bf16_t* ACT; const float* ssq;
    __device__ __forceinline__ bool keep(const Unit&) const { return false; }
    __device__ __forceinline__ void operator()(f32x4 (&acc)[2][2][4][2], const Unit& u, int wr, int wc, int fr, int fq) const {
        const int row0 = u.pm * BM + wr * 64 + fr, col0 = u.pn * 128 + wc * 32 + 8 * fq;
        float rs[8]; rows_rstd8(ssq, row0, fq, rs);
#pragma unroll
        for (int ai = 0; ai < 2; ++ai)
#pragma unroll
            for (int m = 0; m < 4; ++m) {
                const int row = row0 + ai * HALF + m * 16; const float s = rs[ai * 4 + m];
                float o[8];
#pragma unroll
                for (int n = 0; n < 2; ++n)
#pragma unroll
                    for (int i = 0; i < 4; ++i) { const float g1 = acc[ai][0][m][n][i] * s, g3 = acc[ai][1][m][n][i] * s; o[n * 4 + i] = silu_f(g1) * g3; }
                u32x4 w; w.x = cvt_pk_bf16(o[0], o[1]); w.y = cvt_pk_bf16(o[2], o[3]); w.z = cvt_pk_bf16(o[4], o[5]); w.w = cvt_pk_bf16(o[6], o[7]);
                *(u32x4*)(ACT + (size_t)row * DFF + col0) = w;
            }
    }
};
struct EpiResid {
    const float* xp; const float* xs; float* outf; bf16_t* XB; float* ssq_out; float alpha; int base_is_out;
    __device__ __forceinline__ bool keep(const Unit&) const { return false; }
    __device__ __forceinline__ void operator()(f32x4 (&acc)[2][2][4][2], const Unit& u, int wr, int wc, int fr, int fq) const {
        const int row0 = u.pm * BM + wr * 64 + fr, col0 = u.pn * BM + wc * 32 + 8 * fq;
#pragma unroll
        for (int ai = 0; ai < 2; ++ai)
#pragma unroll
            for (int m = 0; m < 4; ++m) {
                const int row = row0 + ai * HALF + m * 16; const bool valid = row < MREAL;
                const float* bp = base_is_out ? outf + (size_t)row * DM : (row < NPROMPT ? xp + (size_t)row * DM : xs + (size_t)(row - NPROMPT) * DM);
                float q = 0.f;
#pragma unroll
                for (int bj = 0; bj < 2; ++bj) {
                    const int c = col0 + bj * HALF;
                    f32x4 b0 = (f32x4){0.f, 0.f, 0.f, 0.f}, b1 = b0;
                    if (valid) { b0 = *(const f32x4*)(bp + c); b1 = *(const f32x4*)(bp + c + 4); }
                    const f32x4 v0 = b0 + acc[ai][bj][m][0] * alpha, v1 = b1 + acc[ai][bj][m][1] * alpha;
                    q += (v0.x * v0.x + v0.y * v0.y) + (v0.z * v0.z + v0.w * v0.w) + (v1.x * v1.x + v1.y * v1.y) + (v1.z * v1.z + v1.w * v1.w);
                    if (valid) { *(f32x4*)(outf + (size_t)row * DM + c) = v0; *(f32x4*)(outf + (size_t)row * DM + c + 4) = v1; }
                    if (XB) { u32x4 w; w.x = cvt_pk_bf16(v0.x, v0.y); w.y = cvt_pk_bf16(v0.z, v0.w); w.z = cvt_pk_bf16(v1.x, v1.y); w.w = cvt_pk_bf16(v1.z, v1.w);
                        *(u32x4*)(XB + (size_t)row * DM + c) = w; }
                }
                q += __shfl_xor(q, 16); q += __shfl_xor(q, 32);
                if (fq == 0) ssq_out[(size_t)row * 16 + u.pn * 4 + wc] = q;
            }
    }
};
struct EpiWin {
    bf16_t *U, *VG, *Q, *KV, *G; const float* ssq1; float* ssqv; float* outf;
    __device__ __forceinline__ bool keep(const Unit&) const { return false; }
    __device__ __forceinline__ void operator()(f32x4 (&acc)[2][2][4][2], const Unit& u, int wr, int wc, int fr, int fq) const {
        const int pn = u.pn;
        bf16_t* dst; int ldd = DM, cbase; int act; float scale = 1.0f; bool want_ssq = false, kvt = false;
        if (pn < 4)       { dst = U;  cbase = pn * 256;        act = 1; }
        else if (pn < 8)  { dst = VG; cbase = (pn - 4) * 256;  act = 1; want_ssq = true; }
        else if (pn < 12) { dst = Q;  cbase = (pn - 8) * 256;  act = 0; scale = QSCALE; }
        else if (pn == 12){ dst = KV; cbase = 0; ldd = 256;    act = 0; kvt = true; }
        else if (pn < 17) { dst = G;  cbase = (pn - 13) * 256; act = 2; }
        else              { dst = G + (size_t)MP * DM; cbase = (pn - 17) * 256; act = 2; }
        const float zc1 = act == 1 ? 1.5957691216057308f : 1.0f, zc3 = act == 1 ? 1.5957691216057308f * 0.044715f : 0.0f;
        const int row0 = u.pm * BM + wr * 64 + fr, c0 = wc * 32 + 8 * fq;
        float rs[8]; rows_rstd8(ssq1, row0, fq, rs);
#pragma unroll
        for (int ai = 0; ai < 2; ++ai)
#pragma unroll
            for (int m = 0; m < 4; ++m) {
                const int row = row0 + ai * HALF + m * 16; const float s = rs[ai * 4 + m];
                float q = 0.f;
#pragma unroll
                for (int bj = 0; bj < 2; ++bj) {
                    const int c = c0 + bj * HALF;
                    float o[8];
#pragma unroll
                    for (int n = 0; n < 2; ++n)
#pragma unroll
                        for (int i = 0; i < 4; ++i) {
                            const float x = acc[ai][bj][m][n][i] * s;
                            const float sg = fast_sigmoid(x * (zc1 + zc3 * x * x));
                            float v = act == 0 ? x * scale : (act == 1 ? x * sg : sg);
                            q += v * v;
                            o[n * 4 + i] = v;
                        }
                    u32x4 w; w.x = cvt_pk_bf16(o[0], o[1]); w.y = cvt_pk_bf16(o[2], o[3]); w.z = cvt_pk_bf16(o[4], o[5]); w.w = cvt_pk_bf16(o[6], o[7]);
                    *(u32x4*)(dst + (size_t)row * ldd + cbase + c) = w;
                    if (kvt) {
                        const int rowu = __builtin_amdgcn_readfirstlane(row);
                        const int tu = rowu & (SEQ - 1);
                        if (rowu < NPROMPT ? (tu >= SEQ - 128) : (rowu < MREAL)) {
                            float* fd = rowu < NPROMPT ? outf + (bj == 0 ? OFF_KP : OFF_VP) + ((size_t)(row >> 13) * 128 + ((row & (SEQ - 1)) - (SEQ - 128))) * 128 + c0
                                                       : outf + (bj == 0 ? OFF_KS : OFF_VS) + (size_t)(row - NPROMPT) * 128 + c0;
                            *(f32x4*)fd = (f32x4){o[0], o[1], o[2], o[3]}; *(f32x4*)(fd + 4) = (f32x4){o[4], o[5], o[6], o[7]};
                        }
                    }
                }
                if (want_ssq) { q += __shfl_xor(q, 16); q += __shfl_xor(q, 32); if (fq == 0) ssqv[(size_t)row * 16 + (pn - 4) * 4 + wc] = q; }
            }
    }
};
struct EpiGate {
    const bf16_t* G; bf16_t* MB; int second;
    __device__ __forceinline__ bool keep(const Unit&) const { return false; }
    __device__ __forceinline__ void operator()(f32x4 (&acc)[2][2][4][2], const Unit& u, int wr, int wc, int fr, int fq) const {
        const int row0 = u.pm * BM + wr * 64 + fr, col0 = u.pn * BM + wc * 32 + 8 * fq;
        const bf16_t* Gs = G + (second ? (size_t)MP * DM : (size_t)0);
#pragma unroll
        for (int ai = 0; ai < 2; ++ai)
#pragma unroll
            for (int m = 0; m < 4; ++m) {
                const int row = row0 + ai * HALF + m * 16;
#pragma unroll
                for (int bj = 0; bj < 2; ++bj) {
                    const int c = col0 + bj * HALF;
                    const u32x4 gg = *(const u32x4*)(Gs + (size_t)row * DM + c);
                    const float gv[8] = {bf_lo(gg.x), bf_hi(gg.x), bf_lo(gg.y), bf_hi(gg.y), bf_lo(gg.z), bf_hi(gg.z), bf_lo(gg.w), bf_hi(gg.w)};
                    float o[8];
#pragma unroll
                    for (int n = 0; n < 2; ++n)
#pragma unroll
                        for (int i = 0; i < 4; ++i) o[n * 4 + i] = acc[ai][bj][m][n][i] * gv[n * 4 + i];
                    if (second) {
                        const u32x4 tt = *(const u32x4*)(MB + (size_t)row * DM + c);
                        o[0] += bf_lo(tt.x); o[1] += bf_hi(tt.x); o[2] += bf_lo(tt.y); o[3] += bf_hi(tt.y); o[4] += bf_lo(tt.z); o[5] += bf_hi(tt.z); o[6] += bf_lo(tt.w); o[7] += bf_hi(tt.w);
                    }
                    u32x4 w; w.x = cvt_pk_bf16(o[0], o[1]); w.y = cvt_pk_bf16(o[2], o[3]); w.z = cvt_pk_bf16(o[4], o[5]); w.w = cvt_pk_bf16(o[6], o[7]);
                    *(u32x4*)(MB + (size_t)row * DM + c) = w;
                }
            }
    }
};
struct EpiPlain {
    bf16_t* O;
    __device__ __forceinline__ bool keep(const Unit&) const { return false; }
    __device__ __forceinline__ void operator()(f32x4 (&acc)[2][2][4][2], const Unit& u, int wr, int wc, int fr, int fq) const {
        const int row0 = u.pm * BM + wr * 64 + fr, col0 = u.pn * BM + wc * 32 + 8 * fq;
#pragma unroll
        for (int ai = 0; ai < 2; ++ai)
#pragma unroll
            for (int m = 0; m < 4; ++m) {
                const int row = row0 + ai * HALF + m * 16;
#pragma unroll
                for (int bj = 0; bj < 2; ++bj) {
                    const int c = col0 + bj * HALF;
                    const f32x4 a = acc[ai][bj][m][0], b = acc[ai][bj][m][1];
                    u32x4 w; w.x = cvt_pk_bf16(a.x, a.y); w.y = cvt_pk_bf16(a.z, a.w); w.z = cvt_pk_bf16(b.x, b.y); w.w = cvt_pk_bf16(b.z, b.w);
                    *(u32x4*)(O + (size_t)row * DM + c) = w;
                }
            }
    }
};
}

template <class F>
__device__ __forceinline__ void sample_gemm(LAS unsigned char* lds, const bf16_t* As, const bf16_t* Bt, int K, int jj, int wave, int lane, const F& f) {
    const int fr = lane & 15, fq = lane >> 4, j = jj >> 2, rt = (jj & 3) * 2 + (wave & 1), kq = wave >> 1, K4 = K >> 2;
    const bf16_t* ap = As + (size_t)(rt * 16 + fr) * K + kq * K4 + 8 * fq;
    const bf16_t* bp = Bt + (size_t)(j * 16 + fr) * K + kq * K4 + 8 * fq;
    f32x4 acc0 = (f32x4){0.f, 0.f, 0.f, 0.f}, acc1 = acc0;
    int k = 0;
#pragma unroll 1
    for (; k + 256 <= K4; k += 256) {
        bf16x8 a[8], b[8];
#pragma unroll
        for (int t = 0; t < 8; ++t) { a[t] = *(const bf16x8*)(ap + k + 32 * t); b[t] = *(const bf16x8*)(bp + k + 32 * t); }
        __builtin_amdgcn_sched_barrier(0);
#pragma unroll
        for (int t = 0; t < 8; t += 2) { acc0 = __builtin_amdgcn_mfma_f32_16x16x32_bf16(b[t], a[t], acc0, 0, 0, 0); acc1 = __builtin_amdgcn_mfma_f32_16x16x32_bf16(b[t + 1], a[t + 1], acc1, 0, 0, 0); }
        __builtin_amdgcn_sched_barrier(0);
    }
#pragma unroll 1
    for (; k < K4; k += 192) {
        bf16x8 a[6], b[6];
#pragma unroll
        for (int t = 0; t < 6; ++t) { a[t] = *(const bf16x8*)(ap + k + 32 * t); b[t] = *(const bf16x8*)(bp + k + 32 * t); }
        __builtin_amdgcn_sched_barrier(0);
#pragma unroll
        for (int t = 0; t < 6; t += 2) { acc0 = __builtin_amdgcn_mfma_f32_16x16x32_bf16(b[t], a[t], acc0, 0, 0, 0); acc1 = __builtin_amdgcn_mfma_f32_16x16x32_bf16(b[t + 1], a[t + 1], acc1, 0, 0, 0); }
        __builtin_amdgcn_sched_barrier(0);
    }
    f32x4 acc = acc0 + acc1;
    LAS f32x4* xch = (LAS f32x4*)lds;
    if (kq > 0) xch[((kq - 1) * 2 + (wave & 1)) * 64 + lane] = acc;
    __syncthreads();
    if (kq == 0) { acc += xch[(0 * 2 + (wave & 1)) * 64 + lane]; acc += xch[(1 * 2 + (wave & 1)) * 64 + lane]; acc += xch[(2 * 2 + (wave & 1)) * 64 + lane];
        f(acc, NPROMPT + rt * 16 + fr, j, fq); }
    __syncthreads();
}
struct SkResid {
    const float* base; float* outf; bf16_t* XB; float* ssq_out; float alpha;
    __device__ __forceinline__ void operator()(const f32x4 a, int row, int j, int fq) const {
        const int c = j * 16 + 4 * fq;
        const f32x4 v = *(const f32x4*)(base + (size_t)row * DM + c) + a * alpha;
        float q = (v.x * v.x + v.y * v.y) + (v.z * v.z + v.w * v.w);
        *(f32x4*)(outf + (size_t)row * DM + c) = v;
        if (XB) { u32x2 w; w.x = cvt_pk_bf16(v.x, v.y); w.y = cvt_pk_bf16(v.z, v.w); *(u32x2*)(XB + (size_t)row * DM + c) = w; }
        q += __shfl_xor(q, 16); q += __shfl_xor(q, 32);
        if (fq == 0) atomicAdd(ssq_out + (size_t)row * 16 + (j >> 2), q);
    }
};
struct SkGate {
    const bf16_t* G; bf16_t* MB; int second;
    __device__ __forceinline__ void operator()(const f32x4 a, int row, int j, int fq) const {
        const bf16_t* Gs = G + (second ? (size_t)MP * DM : (size_t)0);
        const int c = j * 16 + 4 * fq;
        const u32x2 gg = *(const u32x2*)(Gs + (size_t)row * DM + c);
        float o0 = a.x * bf_lo(gg.x), o1 = a.y * bf_hi(gg.x), o2 = a.z * bf_lo(gg.y), o3 = a.w * bf_hi(gg.y);
        if (second) { const u32x2 tt = *(const u32x2*)(MB + (size_t)row * DM + c); o0 += bf_lo(tt.x); o1 += bf_hi(tt.x); o2 += bf_lo(tt.y); o3 += bf_hi(tt.y); }
        u32x2 w; w.x = cvt_pk_bf16(o0, o1); w.y = cvt_pk_bf16(o2, o3);
        *(u32x2*)(MB + (size_t)row * DM + c) = w;
    }
};

__device__ __forceinline__ void sample_up(LAS unsigned char* lds, const bf16_t* XBs, const bf16_t* W13, const float* ssq, bf16_t* ACT, int jj, int wave, int lane) {
    const int fr = lane & 15, fq = lane >> 4, j = jj >> 1, rt = (jj & 1) * 4 + (wave & 3), kh = wave >> 2;
    const int c0 = j * 16;
    const bf16_t* ap = XBs + (size_t)(rt * 16 + fr) * DM + kh * 512 + 8 * fq;
    const bf16_t* b1 = W13 + (size_t)((c0 >> 7) * 256 + (c0 & 127) + fr) * DM + kh * 512 + 8 * fq;
    const bf16_t* b3 = b1 + (size_t)128 * DM;
    f32x4 g1 = (f32x4){0.f, 0.f, 0.f, 0.f}, g3 = g1;
#pragma unroll 1
    for (int k = 0; k < 512; k += 256) {
        bf16x8 a[8], p[8], q[8];
#pragma unroll
        for (int t = 0; t < 8; ++t) { a[t] = *(const bf16x8*)(ap + k + 32 * t); p[t] = *(const bf16x8*)(b1 + k + 32 * t); q[t] = *(const bf16x8*)(b3 + k + 32 * t); }
        __builtin_amdgcn_sched_barrier(0);
#pragma unroll
        for (int t = 0; t < 8; ++t) { g1 = __builtin_amdgcn_mfma_f32_16x16x32_bf16(p[t], a[t], g1, 0, 0, 0); g3 = __builtin_amdgcn_mfma_f32_16x16x32_bf16(q[t], a[t], g3, 0, 0, 0); }
        __builtin_amdgcn_sched_barrier(0);
    }
    LAS f32x4* xch = (LAS f32x4*)lds;
    if (kh == 1) { xch[((wave & 3) * 2 + 0) * 64 + lane] = g1; xch[((wave & 3) * 2 + 1) * 64 + lane] = g3; }
    __syncthreads();
    if (kh == 0) {
        g1 += xch[((wave & 3) * 2 + 0) * 64 + lane]; g3 += xch[((wave & 3) * 2 + 1) * 64 + lane];
        const int row = NPROMPT + rt * 16 + fr;
        const f32x4* sp = (const f32x4*)(ssq + (size_t)row * 16); const f32x4 s0 = sp[0], s1 = sp[1], s2 = sp[2], s3 = sp[3];
        const float ss = ((s0.x + s0.y) + (s0.z + s0.w)) + ((s1.x + s1.y) + (s1.z + s1.w)) + ((s2.x + s2.y) + (s2.z + s2.w)) + ((s3.x + s3.y) + (s3.z + s3.w));
        const float rs = rsqrtf(ss * (1.0f / DM) + EPS);
        u32x2 w; w.x = cvt_pk_bf16(silu_f(g1.x * rs) * (g3.x * rs), silu_f(g1.y * rs) * (g3.y * rs)); w.y = cvt_pk_bf16(silu_f(g1.z * rs) * (g3.z * rs), silu_f(g1.w * rs) * (g3.w * rs));
        *(u32x2*)(ACT + (size_t)row * DFF + c0 + 4 * fq) = w;
    }
    __syncthreads();
}

__device__ __forceinline__ void p0_transpose_item(const float* W, int K, int N, const float* gain, bf16_t* WT, int k0, int n0, int drow0, LAS float* scr, int lane) {
    const int c = lane & 7;
    f32x4 ga = (f32x4){1.f, 1.f, 1.f, 1.f}, gb = ga;
    if (gain) { ga = *(const f32x4*)(gain + k0 + 8 * c); gb = *(const f32x4*)(gain + k0 + 8 * c + 4); }
#pragma unroll 16
    for (int i = 0; i < 32; ++i) { const int kk = 2 * i + (lane >> 5); scr[kk * 33 + (lane & 31)] = W[(size_t)(k0 + kk) * N + n0 + (lane & 31)]; }
    asm volatile("s_waitcnt lgkmcnt(0)" ::: "memory");
#pragma unroll
    for (int j = 0; j < 4; ++j) { const int n = (lane >> 3) + 8 * j; const LAS float* s = scr + (8 * c) * 33 + n;
        u32x4 o; o.x = cvt_pk_bf16(s[0 * 33] * ga.x, s[1 * 33] * ga.y); o.y = cvt_pk_bf16(s[2 * 33] * ga.z, s[3 * 33] * ga.w); o.z = cvt_pk_bf16(s[4 * 33] * gb.x, s[5 * 33] * gb.y); o.w = cvt_pk_bf16(s[6 * 33] * gb.z, s[7 * 33] * gb.w);
        *(u32x4*)(WT + (size_t)(drow0 + n) * K + k0 + 8 * c) = o; }
    asm volatile("s_waitcnt lgkmcnt(0)" ::: "memory");
}
__device__ __forceinline__ void p0_matrix_item(const float* W, int K, int N, const float* gain, bf16_t* WT, int mode, int item, LAS float* scr, int lane) {
    const int nblk = N / 32, kb = item / nblk, nb = item % nblk, n0 = 32 * nb;
    const int drow0 = mode == 0 ? n0 : ((n0 >> 7) * 256 + (n0 & 127) + (mode == 2 ? 128 : 0));
    p0_transpose_item(W, K, N, gain, WT, 64 * kb, n0, drow0, scr, lane);
}

constexpr int KIMG_PITCH = 144, KIMG_OFF = 0;
constexpr int VT_PITCH = 528, VT_OFF = 36864;
constexpr int VN_PITCH = 272, VN_OFF = 70656;
constexpr int RSV_OFF = 105472;
__device__ __forceinline__ int vt_addr(int d, int tp) { return VT_OFF + d * VT_PITCH + ((((tp) >> 2) ^ ((d) >> 3)) << 4) + ((tp) & 3) * 4; }
__device__ __forceinline__ int vn_addr(int d, int tp) { return VN_OFF + d * VN_PITCH + ((((tp) >> 2) ^ ((d) >> 3)) << 4) + ((tp) & 3) * 4; }

#define TR_WRITE8(ADDRF, ch0, tp, a, b) do { \
    const unsigned a_[4] = {(a).x, (a).y, (a).z, (a).w}, b_[4] = {(b).x, (b).y, (b).z, (b).w}; \
    _Pragma("unroll") for (int p_ = 0; p_ < 4; ++p_) { \
        *(LAS unsigned*)(lds + ADDRF((ch0) + 2 * p_, (tp))) = (a_[p_] & 0xffffu) | (b_[p_] << 16); \
        *(LAS unsigned*)(lds + ADDRF((ch0) + 2 * p_ + 1, (tp))) = (a_[p_] >> 16) | (b_[p_] & 0xffff0000u); } } while (0)

__device__ __forceinline__ void attn_qsub(LAS unsigned char* lds, int win, int kt_lo, int kt_hi, const bf16x8 q0, const bf16x8 q1, bf16_t* optr, float sink2, int fr, int fq) {
    f32x4 S[12];
#pragma unroll
    for (int kt = 0; kt < 12; ++kt) {
        if (kt >= kt_lo && kt < kt_hi) {
            const LAS unsigned char* kp = lds + KIMG_OFF + (win + kt * 16 + fr) * KIMG_PITCH + fq * 16;
            const bf16x8 a0 = *(const LAS bf16x8*)kp, a1 = *(const LAS bf16x8*)(kp + 64);
            f32x4 z = (f32x4){0.f, 0.f, 0.f, 0.f};
            z = __builtin_amdgcn_mfma_f32_16x16x32_bf16(a0, q0, z, 0, 0, 0);
            S[kt] = __builtin_amdgcn_mfma_f32_16x16x32_bf16(a1, q1, z, 0, 0, 0);
        } else S[kt] = (f32x4){-INFINITY, -INFINITY, -INFINITY, -INFINITY};
        if (kt & 1) __builtin_amdgcn_sched_barrier(0);
    }
    float mx = sink2;
#pragma unroll
    for (int kt = 0; kt < 12; ++kt) mx = fmaxf(fmaxf(mx, fmaxf(S[kt].x, S[kt].y)), fmaxf(S[kt].z, S[kt].w));
    mx = fmaxf(mx, __shfl_xor(mx, 16)); mx = fmaxf(mx, __shfl_xor(mx, 32));
    float l = 0.f;
#pragma unroll
    for (int kt = 0; kt < 12; ++kt) {
#pragma unroll
        for (int i = 0; i < 4; ++i) { const float p = __builtin_amdgcn_exp2f(S[kt][i] - mx); S[kt][i] = p; l += p; }
    }
    l += __shfl_xor(l, 16); l += __shfl_xor(l, 32);
    l += __builtin_amdgcn_exp2f(sink2 - mx);
    f32x4 O[4];
#pragma unroll
    for (int dt = 0; dt < 4; ++dt) O[dt] = (f32x4){0.f, 0.f, 0.f, 0.f};
#pragma unroll
    for (int s = 0; s < 6; ++s) {
        if (2 * s + 1 >= kt_lo && 2 * s < kt_hi) {
            u32x4 pw; pw.x = cvt_pk_bf16(S[2 * s].x, S[2 * s].y); pw.y = cvt_pk_bf16(S[2 * s].z, S[2 * s].w); pw.z = cvt_pk_bf16(S[2 * s + 1].x, S[2 * s + 1].y); pw.w = cvt_pk_bf16(S[2 * s + 1].z, S[2 * s + 1].w);
            const bf16x8 pf = __builtin_bit_cast(bf16x8, pw);
            const int tp = (win >> 1) + 16 * s + 2 * fq;
#pragma unroll
            for (int dt = 0; dt < 4; ++dt) {
                const int d = dt * 16 + fr;
                const u32x2 lo = *(const LAS u32x2*)(lds + vt_addr(d, tp)), hi = *(const LAS u32x2*)(lds + vt_addr(d, tp + 8));
                const u32x4 vv = (u32x4){lo.x, lo.y, hi.x, hi.y};
                O[dt] = __builtin_amdgcn_mfma_f32_16x16x32_bf16(__builtin_bit_cast(bf16x8, vv), pf, O[dt], 0, 0, 0);
            }
        }
        __builtin_amdgcn_sched_barrier(0);
    }
    const float rl = __builtin_amdgcn_rcpf(l);
#pragma unroll
    for (int dt = 0; dt < 4; ++dt) { u32x2 w; w.x = cvt_pk_bf16(O[dt].x * rl, O[dt].y * rl); w.y = cvt_pk_bf16(O[dt].z * rl, O[dt].w * rl); *(u32x2*)(optr + dt * 16) = w; }
}

struct MixArgs {
    bf16_t *U, *VG, *Q; const bf16_t* KV; const bf16_t* WM; const float* ssqv; const float* gmn; const float* gm_ws; const float* gm_bs; const float* sinks;
    const float* cache_k; const float* cache_v; float* gvout;
};

__device__ __forceinline__ void mix_prompt_unit(LAS unsigned char* lds, const MixArgs& A, int b, int cc) {
    const int tid = threadIdx.x, lane = tid & 63, wave = __builtin_amdgcn_readfirstlane(tid >> 6), fr = lane & 15, fq = lane >> 4;
    const int t0 = cc * 128; const size_t R0 = (size_t)b * SEQ + t0;
    LAS float* rsv = (LAS float*)(lds + RSV_OFF);
    __syncthreads();
    if (tid < 128) { const f32x4* p = (const f32x4*)(A.ssqv + (R0 + tid) * 16); const f32x4 a = p[0], b4 = p[1], c = p[2], d = p[3];
        const float s = ((a.x + a.y) + (a.z + a.w)) + ((b4.x + b4.y) + (b4.z + b4.w)) + ((c.x + c.y) + (c.z + c.w)) + ((d.x + d.y) + (d.z + d.w));
        rsv[tid] = rsqrtf(s * (1.0f / DM) + EPS); }
#ifndef MK_NOATT
    for (int kvh = 0; kvh < 2; ++kvh) {
        __syncthreads();
#pragma unroll
        for (int it = 0; it < 4; ++it) {
            const int idx = tid + it * NTHREADS, row = idx >> 3, ch = idx & 7, tok = t0 - 128 + row;
            u32x4 v = (u32x4){0u, 0u, 0u, 0u};
            if (tok >= 0) v = *(const u32x4*)(A.KV + ((size_t)b * SEQ + tok) * 256 + kvh * 64 + ch * 8);
            *(LAS u32x4*)(lds + KIMG_OFF + row * KIMG_PITCH + ch * 16) = v;
        }
#pragma unroll
        for (int it = 0; it < 2; ++it) {
            const int idx = tid + it * NTHREADS, tp = idx >> 3, ch = idx & 7, tok = t0 - 128 + 2 * tp;
            u32x4 va = (u32x4){0u, 0u, 0u, 0u}, vb = va;
            if (tok >= 0) { const bf16_t* p = A.KV + ((size_t)b * SEQ + tok) * 256 + 128 + kvh * 64 + ch * 8; va = *(const u32x4*)p; vb = *(const u32x4*)(p + 256); }
            TR_WRITE8(vt_addr, ch * 8, tp, va, vb);
        }
        __syncthreads();
        const int head = kvh * 8 + wave;
        const float sink2 = A.sinks[head] * LOG2E;
        const bf16_t* qbase = A.Q + (R0 + fr) * DM + head * 64 + 8 * fq;
        bf16x8 q0 = *(const bf16x8*)qbase, q1 = *(const bf16x8*)(qbase + 32);
#pragma unroll 1
        for (int qs = 0; qs < 8; ++qs) {
            const int qc = qs >> 2;
            const int kt_lo = (t0 == 0) ? 4 * (2 - qc) : 0;
            const size_t row = R0 + qs * 16 + fr;
            const bf16_t* qn = qbase + (size_t)(qs < 7 ? qs + 1 : qs) * 16 * DM;
            const bf16x8 n0 = *(const bf16x8*)qn, n1 = *(const bf16x8*)(qn + 32);
            attn_qsub(lds, qc * 64, kt_lo, 12, q0, q1, A.Q + row * DM + head * 64 + 4 * fq, sink2, fr, fq);
            q0 = n0; q1 = n1;
        }
    }
#endif
#ifndef MK_NOGMLP
#define VN2_ADDR(d_, tp_) ((d_) * 272 + (((((tp_)) >> 2) ^ ((d_) >> 3)) << 4) + ((tp_) & 3) * 4)
#pragma unroll 1
    for (int g = 0; g < 8; ++g) {
        __syncthreads();
#pragma unroll
        for (int it = 0; it < 2; ++it) {
            const int idx = tid + it * NTHREADS, tp = idx >> 4, ch = idx & 15;
            const bf16_t* p = A.VG + (R0 + 2 * tp) * DM + g * 128 + ch * 8;
            const u32x4 va = *(const u32x4*)p, vb = *(const u32x4*)(p + DM);
            const float ra = rsv[2 * tp], rb = rsv[2 * tp + 1];
            const f32x4 g0 = *(const f32x4*)(A.gmn + g * 128 + ch * 8), g1 = *(const f32x4*)(A.gmn + g * 128 + ch * 8 + 4);
            u32x4 sa, sb;
            sa.x = cvt_pk_bf16(bf_lo(va.x) * ra * g0.x, bf_hi(va.x) * ra * g0.y); sa.y = cvt_pk_bf16(bf_lo(va.y) * ra * g0.z, bf_hi(va.y) * ra * g0.w);
            sa.z = cvt_pk_bf16(bf_lo(va.z) * ra * g1.x, bf_hi(va.z) * ra * g1.y); sa.w = cvt_pk_bf16(bf_lo(va.w) * ra * g1.z, bf_hi(va.w) * ra * g1.w);
            sb.x = cvt_pk_bf16(bf_lo(vb.x) * rb * g0.x, bf_hi(vb.x) * rb * g0.y); sb.y = cvt_pk_bf16(bf_lo(vb.y) * rb * g0.z, bf_hi(vb.y) * rb * g0.w);
            sb.z = cvt_pk_bf16(bf_lo(vb.z) * rb * g1.x, bf_hi(vb.z) * rb * g1.y); sb.w = cvt_pk_bf16(bf_lo(vb.w) * rb * g1.z, bf_hi(vb.w) * rb * g1.w);
            TR_WRITE8(VN2_ADDR, ch * 8, tp, sa, sb);
        }
        __syncthreads();
#pragma unroll
        for (int ii = 0; ii < 2; ++ii) {
            const int it = ii == 0 ? wave : 7 - wave, ns = it < 4 ? 2 : 4;
            f32x4 acc[4];
#pragma unroll
            for (int ds = 0; ds < 4; ++ds) acc[ds] = (f32x4){0.f, 0.f, 0.f, 0.f};
            const float* wrow = A.gm_ws + ((size_t)(g * 128 + it * 16 + fr)) * 128 + 4 * fq;
#pragma unroll
            for (int sk = 0; sk < 4; ++sk) {
                if (sk < ns) {
                    const f32x4 wl = *(const f32x4*)(wrow + 32 * sk), wh = *(const f32x4*)(wrow + 32 * sk + 16);
                    const bf16x8 wfrag = __builtin_bit_cast(bf16x8, ((u32x4){cvt_pk_bf16(wl.x, wl.y), cvt_pk_bf16(wl.z, wl.w), cvt_pk_bf16(wh.x, wh.y), cvt_pk_bf16(wh.z, wh.w)}));
                    const int tp = 16 * sk + 2 * fq;
#pragma unroll
                    for (int ds = 0; ds < 4; ++ds) {
                        const int d = (ii * 4 + ds) * 16 + fr;
                        const u32x2 lo = *(const LAS u32x2*)(lds + VN2_ADDR(d, tp)), hi = *(const LAS u32x2*)(lds + VN2_ADDR(d, tp + 8));
                        const u32x4 vv = (u32x4){lo.x, lo.y, hi.x, hi.y};
                        acc[ds] = __builtin_amdgcn_mfma_f32_16x16x32_bf16(__builtin_bit_cast(bf16x8, vv), wfrag, acc[ds], 0, 0, 0);
                    }
                    __builtin_amdgcn_sched_barrier(0);
                }
            }
            const int itok = it * 16 + fr;
            const float bias = A.gm_bs[g * 128 + itok];
            bf16_t* up = A.U + (R0 + itok) * DM + g * 128 + ii * 64 + 4 * fq;
#pragma unroll
            for (int ds = 0; ds < 4; ++ds) {
                const u32x2 uu = *(const u32x2*)(up + ds * 16);
                u32x2 w; w.x = cvt_pk_bf16(bf_lo(uu.x) * (acc[ds].x + bias), bf_hi(uu.x) * (acc[ds].y + bias));
                w.y = cvt_pk_bf16(bf_lo(uu.y) * (acc[ds].z + bias), bf_hi(uu.y) * (acc[ds].w + bias));
                *(u32x2*)(up + ds * 16) = w;
            }
            __builtin_amdgcn_sched_barrier(0);
        }
    }
#undef VN2_ADDR
#endif
}

__device__ __forceinline__ u32x4 sample_kv8(const float* cache, const bf16_t* KV, int voff, int sb, int key, int kvh, int ch) {
    u32x4 v = (u32x4){0u, 0u, 0u, 0u};
    if (key < 128) { const float* p = cache + (((size_t)sb * 128 + key) * 2 + kvh) * 64 + ch * 8; const f32x4 a = *(const f32x4*)p, b = *(const f32x4*)(p + 4);
        v.x = cvt_pk_bf16(a.x, a.y); v.y = cvt_pk_bf16(a.z, a.w); v.z = cvt_pk_bf16(b.x, b.y); v.w = cvt_pk_bf16(b.z, b.w); }
    else if (key < 144) v = *(const u32x4*)(KV + ((size_t)NPROMPT + sb * 16 + (key - 128)) * 256 + voff + kvh * 64 + ch * 8);
    return v;
}

__device__ __forceinline__ void mix_sample_unit(LAS unsigned char* lds, const MixArgs& A, int sb) {
    const int tid = threadIdx.x, lane = tid & 63, wave = __builtin_amdgcn_readfirstlane(tid >> 6), fr = lane & 15, fq = lane >> 4;
    const size_t R0 = (size_t)NPROMPT + sb * 16;
    LAS float* rsv = (LAS float*)(lds + RSV_OFF);
    __syncthreads();
    if (tid < 16) { const f32x4* p = (const f32x4*)(A.ssqv + (R0 + tid) * 16); const f32x4 a = p[0], b4 = p[1], c = p[2], d = p[3];
        const float s = ((a.x + a.y) + (a.z + a.w)) + ((b4.x + b4.y) + (b4.z + b4.w)) + ((c.x + c.y) + (c.z + c.w)) + ((d.x + d.y) + (d.z + d.w));
        rsv[tid] = rsqrtf(s * (1.0f / DM) + EPS); }
    for (int kvh = 0; kvh < 2; ++kvh) {
        __syncthreads();
        for (int idx = tid; idx < 160 * 8; idx += NTHREADS) {
            const int row = idx >> 3, ch = idx & 7;
            *(LAS u32x4*)(lds + KIMG_OFF + row * KIMG_PITCH + ch * 16) = sample_kv8(A.cache_k, A.KV, 0, sb, row, kvh, ch);
        }
        for (int idx = tid; idx < 80 * 8; idx += NTHREADS) {
            const int tp = idx >> 3, ch = idx & 7;
            const u32x4 va = sample_kv8(A.cache_v, A.KV, 128, sb, 2 * tp, kvh, ch), vb = sample_kv8(A.cache_v, A.KV, 128, sb, 2 * tp + 1, kvh, ch);
            TR_WRITE8(vt_addr, ch * 8, tp, va, vb);
        }
        __syncthreads();
        const int head = kvh * 8 + wave;
        const float sink2 = A.sinks[head] * LOG2E;
        const size_t row = R0 + fr;
        { const bf16_t* qp = A.Q + row * DM + head * 64 + 8 * fq; const bf16x8 q0 = *(const bf16x8*)qp, q1 = *(const bf16x8*)(qp + 32);
          attn_qsub(lds, 0, 0, 9, q0, q1, A.Q + row * DM + head * 64 + 4 * fq, sink2, fr, fq); }
    }
    {
        const int c = 2 * tid, g = wave;
        float v0[16], v1[16];
        const f32x2 gm = *(const f32x2*)(A.gmn + c);
#pragma unroll
        for (int j = 0; j < 16; ++j) {
            const unsigned w = *(const unsigned*)(A.VG + (R0 + j) * DM + c); const float r = rsv[j];
            v0[j] = bf_lo(w) * r * gm.x; v1[j] = bf_hi(w) * r * gm.y;
            *(f32x2*)(A.gvout + ((size_t)sb * 16 + j) * DM + c) = (f32x2){v0[j], v1[j]};
        }
#pragma unroll 1
        for (int i = 0; i < 16; ++i) {
            const float bias = A.gm_bs[g * 128 + i]; float a0 = bias, a1 = bias;
            const float* wrow = A.gm_ws + ((size_t)g * 128 + i) * 128;
#pragma unroll
            for (int j = 0; j < 16; ++j) { const float w = wrow[j]; a0 += w * v0[j]; a1 += w * v1[j]; }
            unsigned* up = (unsigned*)(A.U + (R0 + i) * DM + c); const unsigned uu = *up;
            *up = cvt_pk_bf16(bf_lo(uu) * a0, bf_hi(uu) * a1);
        }
    }
}

#define XB_TMO      128
#define XB_XCNT(j)  (256  + 64 * (j))
#define XB_XSUB(j)  (1280 + 64 * (j))
#define XB_XGEN(j)  (2304 + 64 * (j))
#define XB_TOP      3328
#define XB_TOPGEN   3392
#define XCD_BAR_WORDS 3456
#define XB_SPIN_CAP (1u << 18)
__device__ __forceinline__ unsigned xb_ld(unsigned* p)              { return __hip_atomic_load(p, __ATOMIC_RELAXED, __HIP_MEMORY_SCOPE_AGENT); }
__device__ __forceinline__ unsigned xb_add(unsigned* p, unsigned v) { return __hip_atomic_fetch_add(p, v, __ATOMIC_RELAXED, __HIP_MEMORY_SCOPE_AGENT); }
__device__ __forceinline__ unsigned xb_xcc_id() { return (unsigned)__builtin_amdgcn_s_getreg((3 << 11) | 20) & 0xFu; }
#define XB_SPIN(cond, bar) do { unsigned _sp = 0; while (cond) { __builtin_amdgcn_s_sleep(1); \
    if ((++_sp & 255u) == 0u) { if (xb_ld(&(bar)[XB_TMO])) break; if (_sp > XB_SPIN_CAP) { atomicAdd(&(bar)[XB_TMO], 1u); break; } } } } while (0)
struct XcdBarrier { unsigned* bar; unsigned x; volatile LAS unsigned* st; };
__device__ __forceinline__ XcdBarrier xcd_barrier_post(unsigned* bar, volatile LAS unsigned* st) {
    XcdBarrier b; b.bar = bar; b.x = xb_xcc_id(); b.st = st;
    if (threadIdx.x == 0) (void)xb_add(&bar[XB_XCNT(b.x)], 1u);
    return b;
}
__device__ __forceinline__ void xcd_barrier_complete(unsigned* bar, unsigned x, unsigned& nloc, unsigned& nx) {
    const unsigned G = gridDim.x * gridDim.y * gridDim.z;
    unsigned sum, cnt, mine, sp = 0u;
    for (;;) {
        sum = 0u; cnt = 0u; mine = 0u;
#pragma unroll
        for (unsigned j = 0; j < 16; ++j) { const unsigned c = xb_ld(&bar[XB_XCNT(j)]); sum += c; cnt += (c > 0u) ? 1u : 0u; mine = (j == x) ? c : mine; }
        if (sum == G) break;
        __builtin_amdgcn_s_sleep(1);
        if ((++sp & 255u) == 0u) { if (xb_ld(&bar[XB_TMO])) break; if (sp > XB_SPIN_CAP) { atomicAdd(&bar[XB_TMO], 1u); break; } }
    }
    nloc = mine > 0u ? mine : 1u; nx = cnt > 0u ? cnt : 1u;
}
__device__ __forceinline__ void xcd_barrier(const XcdBarrier& b) {
    asm volatile("s_waitcnt vmcnt(0)" ::: "memory");
    __syncthreads();
    if (threadIdx.x == 0) {
        unsigned* bar = b.bar;
        __builtin_amdgcn_s_waitcnt(0);
        unsigned nloc = b.st[0], nx = b.st[1];
        if (nloc == 0u) { xcd_barrier_complete(bar, b.x, nloc, nx); b.st[0] = nloc; b.st[1] = nx; }
        const unsigned old = xb_add(&bar[XB_XSUB(b.x)], 1u);
        const unsigned gen = old / nloc;
        if (old + 1u == (gen + 1u) * nloc) {
            __builtin_amdgcn_fence(__ATOMIC_RELEASE, "agent");
            asm volatile("s_waitcnt vmcnt(0)" ::: "memory");
            const unsigned og = xb_add(&bar[XB_TOP], 1u);
            const unsigned tg = og / nx;
            if (og + 1u == (tg + 1u) * nx) xb_add(&bar[XB_TOPGEN], 1u);
            else XB_SPIN(xb_ld(&bar[XB_TOPGEN]) == tg, bar);
            __builtin_amdgcn_fence(__ATOMIC_ACQUIRE, "agent");
            xb_add(&bar[XB_XGEN(b.x)], 1u);
            asm volatile("s_waitcnt vmcnt(0)" ::: "memory");
        } else {
            XB_SPIN(xb_ld(&bar[XB_XGEN(b.x)]) == gen, bar);
            __builtin_amdgcn_fence(__ATOMIC_ACQUIRE, "agent");
            asm volatile("s_waitcnt vmcnt(0)" ::: "memory");
        }
    }
    __syncthreads();
}

struct Args { const float* in[22]; float* out; unsigned char* ws; int ph_lo, ph_hi; };
constexpr int NPHASE = 10;

__global__ void __launch_bounds__(NTHREADS, 2) mk_fwd(Args args) {
    extern __shared__ __attribute__((aligned(16))) unsigned char lds_raw[];
    LAS unsigned char* lds = (LAS unsigned char*)lds_raw;
    const int tid = threadIdx.x, lane = tid & 63, wave = __builtin_amdgcn_readfirstlane(tid >> 6);
    const int G = gridDim.x, bx = blockIdx.x;
    unsigned char* ws = args.ws;
    const float* x_prompt = args.in[0]; const float* x_sample = args.in[1];
    float* out = args.out;
    bf16_t* W13_1 = (bf16_t*)(ws + WS_W13_1); bf16_t* W2_1 = (bf16_t*)(ws + WS_W2_1); bf16_t* WIN = (bf16_t*)(ws + WS_WIN); bf16_t* WPA = (bf16_t*)(ws + WS_WPA); bf16_t* WPB = (bf16_t*)(ws + WS_WPB);
    bf16_t* WOUT = (bf16_t*)(ws + WS_WOUT); bf16_t* W13_2 = (bf16_t*)(ws + WS_W13_2); bf16_t* W2_2 = (bf16_t*)(ws + WS_W2_2); bf16_t* WM = (bf16_t*)(ws + WS_WM);
    float* SSQ0 = (float*)(ws + WS_SSQ0); float* SSQ1 = (float*)(ws + WS_SSQ1); float* SSQ2 = (float*)(ws + WS_SSQ2); float* SSQ3 = (float*)(ws + WS_SSQ3); float* SSQV = (float*)(ws + WS_SSQV);
    bf16_t* XB = (bf16_t*)(ws + WS_XB); bf16_t* KV = (bf16_t*)(ws + WS_KV); bf16_t* ACT = (bf16_t*)(ws + WS_ACT); bf16_t* U = (bf16_t*)(ws + WS_U); bf16_t* VG = (bf16_t*)(ws + WS_VG);
    bf16_t* Q = (bf16_t*)(ws + WS_Q); bf16_t* GT = (bf16_t*)(ws + WS_G); bf16_t* MB = VG;
    const int lo = args.ph_lo, hi = args.ph_hi;
    asm volatile("buffer_inv sc1\n\ts_waitcnt vmcnt(0)" ::: "memory");
    volatile LAS unsigned* xst = (volatile LAS unsigned*)(lds + LDS_BYTES - 16);
    if (tid == 0) { xst[0] = 0u; xst[1] = 0u; }
    __syncthreads();
    XcdBarrier xbar; xbar.bar = (unsigned*)ws; xbar.x = 0; xbar.st = xst;
    if (hi - lo > 1) xbar = xcd_barrier_post((unsigned*)ws, xst);
#ifndef MK_MASK
#define MK_MASK 0x7ff
#endif
#define IN(k) (((MK_MASK >> (k)) & 1) && lo <= (k) && (k) < hi)
#define SEAM(k) do { if (lo <= (k) && (k) + 1 < hi) { \
        if ((k) == 0) { \
            asm volatile("s_waitcnt vmcnt(0) lgkmcnt(0)" ::: "memory"); __syncthreads(); \
            if (wave == 0) asm volatile("buffer_wbl2 sc1\n\ts_waitcnt vmcnt(0)" ::: "memory"); \
            cg::this_grid().sync();                                                                \
            if (wave == 0) asm volatile("buffer_inv sc1\n\ts_waitcnt vmcnt(0)" ::: "memory"); \
            __syncthreads(); \
        } else { xcd_barrier(xbar); } \
    } } while (0)

    if (IN(0)) {
#ifndef PROBE_REP0
#define PROBE_REP0 1
#endif
      for (int rep_ = 0; rep_ < PROBE_REP0; ++rep_) {
        const int gw = bx * NWAVES + wave, NGW = G * NWAVES;
        for (int r = gw; r < MP; r += NGW) {
            u32x2* o8 = (u32x2*)(XB + (size_t)r * DM) + lane;
            float s = 0.f;
            if (r < MREAL) {
                const float* xr = r < NPROMPT ? x_prompt + (size_t)r * DM : x_sample + (size_t)(r - NPROMPT) * DM;
#pragma unroll
                for (int j = 0; j < 4; ++j) { const f32x4 v = *((const f32x4*)xr + lane + 64 * j); s += (v.x * v.x + v.y * v.y) + (v.z * v.z + v.w * v.w);
                    u32x2 w; w.x = cvt_pk_bf16(v.x, v.y); w.y = cvt_pk_bf16(v.z, v.w); o8[64 * j] = w; }
            } else {
#pragma unroll
                for (int j = 0; j < 4; ++j) o8[64 * j] = (u32x2){0u, 0u};
            }
            s = wave_sum(s);
            if (lane < 16) { SSQ0[(size_t)r * 16 + lane] = lane == 0 ? s : 0.f; if (r >= NPROMPT) { SSQ1[(size_t)r * 16 + lane] = 0.f; SSQ2[(size_t)r * 16 + lane] = 0.f; SSQ3[(size_t)r * 16 + lane] = 0.f; } }
        }
        for (int e = (bx * NTHREADS + tid) * 4; e < 8 * 128 * 128; e += G * NTHREADS * 4) {
            const f32x4 v = *(const f32x4*)(args.in[11] + e); const int i = (e >> 7) & 127, j = e & 127;
            const bool keepv = (i >> 6) >= (j >> 6);
            u32x2 w; w.x = keepv ? cvt_pk_bf16(v.x, v.y) : 0u; w.y = keepv ? cvt_pk_bf16(v.z, v.w) : 0u;
            *(u32x2*)(WM + e) = w;
        }
        LAS float* scr = (LAS float*)(lds + wave * 16384);
        constexpr int I_UP = (DM / 64) * (DFF / 32), I_DN = (DFF / 64) * (DM / 32), I_IN = (DM / 64) * (NIN / 32), I_SQ = (DM / 64) * (DM / 32);
        constexpr int NITEMS = 4 * I_UP + 2 * I_DN + I_IN + 3 * I_SQ;
        for (int it = gw; it < NITEMS; it += NGW) {
            int r = it;
            if (r < I_UP) { p0_matrix_item(args.in[5], DM, DFF, args.in[4], W13_1, 1, r, scr, lane); continue; } r -= I_UP;
            if (r < I_UP) { p0_matrix_item(args.in[6], DM, DFF, args.in[4], W13_1, 2, r, scr, lane); continue; } r -= I_UP;
            if (r < I_DN) { p0_matrix_item(args.in[7], DFF, DM, nullptr, W2_1, 0, r, scr, lane); continue; } r -= I_DN;
            if (r < I_IN) { p0_matrix_item(args.in[9], DM, NIN, args.in[8], WIN, 0, r, scr, lane); continue; } r -= I_IN;
            if (r < I_SQ) { p0_matrix_item(args.in[14], DM, DM, nullptr, WPA, 0, r, scr, lane); continue; } r -= I_SQ;
            if (r < I_SQ) { p0_matrix_item(args.in[15], DM, DM, nullptr, WPB, 0, r, scr, lane); continue; } r -= I_SQ;
            if (r < I_SQ) { p0_matrix_item(args.in[16], DM, DM, nullptr, WOUT, 0, r, scr, lane); continue; } r -= I_SQ;
            if (r < I_UP) { p0_matrix_item(args.in[18], DM, DFF, args.in[17], W13_2, 1, r, scr, lane); continue; } r -= I_UP;
            if (r < I_UP) { p0_matrix_item(args.in[19], DM, DFF, args.in[17], W13_2, 2, r, scr, lane); continue; } r -= I_UP;
            p0_matrix_item(args.in[20], DFF, DM, nullptr, W2_2, 0, r, scr, lane);
        }
        asm volatile("s_waitcnt vmcnt(0) lgkmcnt(0)" ::: "memory"); __syncthreads();
      }
    }
    SEAM(0);
    if (IN(1)) {
        for (int jj = G - 1 - bx; jj < 352; jj += G) sample_up(lds, XB + (size_t)NPROMPT * DM, W13_1, SSQ0, ACT, jj, wave, lane);
        pg8::Gemm g{XB, W13_1, DM, 0, 0}; pg8::StaticOrder S; S.init(NPROMPT, NUP, G, bx, 0);
        pg8::EpiSwiglu E{ACT, SSQ0};
        pg8::gemm_phase(lds, g, S, E);
    }
    SEAM(1);
    if (IN(2)) {
        for (int jj_ = bx; jj_ < 256; jj_ += G) { SkResid F{x_sample - (size_t)NPROMPT * DM, out, XB, SSQ1, 0.5f}; sample_gemm(lds, ACT + (size_t)NPROMPT * DFF, W2_1, DFF, jj_, wave, lane, F); }
        pg8::Gemm g{ACT, W2_1, DFF, 0, 0}; pg8::StaticOrder S; S.init(NPROMPT, DM, G, bx, 0);
        pg8::EpiResid E{x_prompt, x_sample, out, XB, SSQ1, 0.5f, 0};
        pg8::gemm_phase(lds, g, S, E);
    }
    SEAM(2);
    if (IN(3)) {
        pg8::Gemm g{XB, WIN, DM, 0, 0}; pg8::StaticOrder S; S.init(MP, NIN, G, bx, 0);
        pg8::EpiWin E{U, VG, Q, KV, GT, SSQ1, SSQV, out};
        pg8::gemm_phase(lds, g, S, E);
    }
    SEAM(3);
    if (IN(4)) {
        MixArgs A{U, VG, Q, KV, WM, SSQV, args.in[10], args.in[11], args.in[12], args.in[13], args.in[2], args.in[3], out + OFF_GV};
#pragma unroll 1
        for (int v = bx; v < 256; v += G) mix_prompt_unit(lds, A, v >> 6, v & 63);
        __builtin_amdgcn_sched_barrier(0);
#pragma unroll 1
        for (int v = G - 1 - bx; v < 8; v += G) mix_sample_unit(lds, A, v);
        asm volatile("s_waitcnt vmcnt(0) lgkmcnt(0)" ::: "memory"); __syncthreads();
    }
    SEAM(4);
    if (IN(5)) {
        {
            for (int jj_ = bx; jj_ < 256; jj_ += G) { SkGate F{GT, MB, 0}; sample_gemm(lds, U + (size_t)NPROMPT * DM, WPA, DM, jj_, wave, lane, F); }
            pg8::Gemm g{U, WPA, DM, 0, 0}; pg8::StaticOrder S; S.init(NPROMPT, DM, G, bx, 0);
            pg8::EpiGate E{GT, MB, 0};
            pg8::gemm_phase(lds, g, S, E);
        }
        {
            for (int jj_ = bx; jj_ < 256; jj_ += G) { SkGate F{GT, MB, 1}; sample_gemm(lds, Q + (size_t)NPROMPT * DM, WPB, DM, jj_, wave, lane, F); }
            pg8::Gemm g{Q, WPB, DM, 0, 0}; pg8::StaticOrder S; S.init(NPROMPT, DM, G, bx, 0);
            pg8::EpiGate E{GT, MB, 1};
            pg8::gemm_phase(lds, g, S, E);
        }
    }
    SEAM(5);
    if (IN(6)) {
        for (int jj_ = bx; jj_ < 256; jj_ += G) { SkResid F{out, out, XB, SSQ2, 1.0f}; sample_gemm(lds, MB + (size_t)NPROMPT * DM, WOUT, DM, jj_, wave, lane, F); }
        pg8::Gemm g{MB, WOUT, DM, 0, 0}; pg8::StaticOrder S; S.init(NPROMPT, DM, G, bx, 0);
        pg8::EpiResid E{x_prompt, x_sample, out, XB, SSQ2, 1.0f, 1};
        pg8::gemm_phase(lds, g, S, E);
    }
    SEAM(6);
    if (IN(7)) {
        for (int jj = G - 1 - bx; jj < 352; jj += G) sample_up(lds, XB + (size_t)NPROMPT * DM, W13_2, SSQ2, ACT, jj, wave, lane);
        pg8::Gemm g{XB, W13_2, DM, 0, 0}; pg8::StaticOrder S; S.init(NPROMPT, NUP, G, bx, 0);
        pg8::EpiSwiglu E{ACT, SSQ2};
        pg8::gemm_phase(lds, g, S, E);
    }
    SEAM(7);
    if (IN(8)) {
        for (int jj_ = bx; jj_ < 256; jj_ += G) { SkResid F{out, out, nullptr, SSQ3, 0.5f}; sample_gemm(lds, ACT + (size_t)NPROMPT * DFF, W2_2, DFF, jj_, wave, lane, F); }
        pg8::Gemm g{ACT, W2_2, DFF, 0, 0}; pg8::StaticOrder S; S.init(NPROMPT, DM, G, bx, 0);
        pg8::EpiResid E{x_prompt, x_sample, out, nullptr, SSQ3, 0.5f, 1};
        pg8::gemm_phase(lds, g, S, E);
    }
    SEAM(8);
    if (IN(9)) {
        const int gw = bx * NWAVES + wave, NGW = G * NWAVES;
        const float* nf = args.in[21];
        f32x4 gn[4];
#pragma unroll
        for (int j = 0; j < 4; ++j) gn[j] = *((const f32x4*)nf + lane + 64 * j);
        for (int r = gw; r < MREAL; r += NGW) {
            const f32x4* sp = (const f32x4*)(SSQ3 + (size_t)r * 16); const f32x4 a = sp[0], b4 = sp[1], c = sp[2], d = sp[3];
            const float s = ((a.x + a.y) + (a.z + a.w)) + ((b4.x + b4.y) + (b4.z + b4.w)) + ((c.x + c.y) + (c.z + c.w)) + ((d.x + d.y) + (d.z + d.w));
            const float rs = rsqrtf(s * (1.0f / DM) + EPS);
            f32x4* xr = (f32x4*)(out + (size_t)r * DM) + lane;
#pragma unroll
            for (int j = 0; j < 4; ++j) { const f32x4 v = xr[64 * j]; xr[64 * j] = v * rs * gn[j]; }
        }
    }
    asm volatile("s_waitcnt vmcnt(0) lgkmcnt(0)\n\tbuffer_wbl2 sc1\n\ts_waitcnt vmcnt(0)" ::: "memory");
#undef IN
#undef SEAM
}

extern "C" void kernel_launch(void* const* d_in, const int* in_sizes, int n_in, void* d_out, int out_size, void* d_ws, size_t ws_size, hipStream_t stream) {
    static int grid = 0;
    if (grid == 0) {
        if (n_in != 22 || ws_size < WS_END) { fprintf(stderr, "kernel_launch: unexpected n_in %d / ws_size %zu (need %zu)\n", n_in, ws_size, (size_t)WS_END); grid = -1; return; }
        int dev = 0, cus = 0, per_cu = 0;
        hipGetDevice(&dev); hipDeviceGetAttribute(&cus, hipDeviceAttributeMultiprocessorCount, dev);
        if (hipFuncSetAttribute((const void*)mk_fwd, hipFuncAttributeMaxDynamicSharedMemorySize, LDS_BYTES) != hipSuccess) { fprintf(stderr, "kernel_launch: hipFuncSetAttribute failed\n"); grid = -1; return; }
        if (hipOccupancyMaxActiveBlocksPerMultiprocessor(&per_cu, (const void*)mk_fwd, NTHREADS, LDS_BYTES) != hipSuccess || per_cu < 1) { fprintf(stderr, "kernel_launch: occupancy query says %d\n", per_cu); (void)hipGetLastError(); grid = -1; return; }
        grid = cus;
    }
    if (grid < 0) return;
    Args a{};
    for (int i = 0; i < 22; ++i) a.in[i] = (const float*)d_in[i];
    a.out = (float*)d_out; a.ws = (unsigned char*)d_ws;
#if MK_MULTI
    { const int order[11] = {0, 1, 2, 3, 4, 5, 10, 6, 7, 8, 9};
      for (int q = 0; q < 11; ++q) { const int p = order[q]; a.ph_lo = p; a.ph_hi = p + 1; hipLaunchKernelGGL(mk_fwd, dim3(grid), dim3(NTHREADS), LDS_BYTES, stream, a); } }
#else
    a.ph_lo = 0; a.ph_hi = NPHASE;
    if (hipMemsetAsync(d_ws, 0, XCD_BAR_WORDS * 4, stream) != hipSuccess) { fprintf(stderr, "kernel_launch: memset of the barrier words failed\n"); return; }
    void* kargs[] = {&a};
    hipError_t e = hipLaunchCooperativeKernel((const void*)mk_fwd, dim3(grid), dim3(NTHREADS), kargs, LDS_BYTES, stream);
    if (e != hipSuccess) fprintf(stderr, "kernel_launch: cooperative launch failed: %s (grid %d)\n", hipGetErrorString(e), grid);
#endif
}
```
